# Optimizing an MI355X kernel written in HIP

```python
import math
import jax, jax.numpy as jnp
from jax import lax
import numpy as np

D_MODEL = 1024
BATCH = 32
SEQ = 256
DEPTH = 2
DEC_BATCH = 2
DEC_SEQ = 2048
PAST_LEN = 512

GRID_W = 64
ROPE_THETA = 10000.0
NORM_EPS = 1e-6
Q_BLOCK = 128

D_MIX = D_MODEL
BRANCH = D_MIX // 4

HEAD_DIM = 64
GQA_HEADS = BRANCH // HEAD_DIM
GQA_KV_HEADS = GQA_HEADS // 2

GLA_HEADS = 4
GLA_DV = BRANCH // GLA_HEADS
GLA_DK = GLA_DV // 2
GLA_LR = 16
GLA_TAU = 16.0
GLA_CHUNK = 64

MLA_HEADS = 4
MLA_V = BRANCH // MLA_HEADS
MLA_NOPE = 64
MLA_ROPE = 32
MLA_Q_RANK = 3 * D_MODEL // 16
MLA_KV_RANK = D_MODEL // 8

SSD_HEADS = 4
SSD_HEAD_DIM = BRANCH // SSD_HEADS
SSD_GROUPS = 2
SSD_STATE = 64
SSD_CONV = 5
SSD_CHUNK = 64
SSD_CONV_CH = BRANCH + 2 * SSD_GROUPS * SSD_STATE

PROJ_SIZES = (
    GQA_HEADS * HEAD_DIM, GQA_KV_HEADS * HEAD_DIM, GQA_KV_HEADS * HEAD_DIM, BRANCH,
    GLA_HEADS * GLA_DK, GLA_HEADS * GLA_DK, GLA_HEADS * GLA_DV, 2 * GLA_LR, BRANCH,
    MLA_Q_RANK, MLA_KV_RANK, MLA_ROPE, BRANCH,
    BRANCH, SSD_CONV_CH, 2 * SSD_HEADS,
)
PROJ_SPLITS = tuple(sum(PROJ_SIZES[:i + 1]) for i in range(len(PROJ_SIZES) - 1))
PROJ_DIM = sum(PROJ_SIZES)

kernel_name = "hybrid_prefix_diffusion_trunk_step"

F32 = jnp.float32


def rms_norm(x, g):
    xf = x.astype(F32)
    y = xf * lax.rsqrt(jnp.mean(xf * xf, axis=-1, keepdims=True) + NORM_EPS)
    return (y * g.astype(F32)).astype(x.dtype)


def axial_rope_angles(n_tok, rot_dim):
    rows = n_tok // GRID_W
    row = jnp.repeat(jnp.arange(rows), GRID_W).astype(F32)
    col = jnp.tile(jnp.arange(GRID_W), rows).astype(F32)
    n_freq = rot_dim // 4
    inv = ROPE_THETA ** (-jnp.arange(n_freq, dtype=F32) / n_freq)
    ang = jnp.stack([row[:, None] * inv, col[:, None] * inv], axis=1)
    return jnp.cos(ang), jnp.sin(ang)


def apply_axial_rope(x, cos, sin):
    B, N, H, R = x.shape
    nf = R // 4
    xr = x.astype(F32).reshape(B, N, H, 2, 2, nf)
    x1, x2 = xr[..., 0, :], xr[..., 1, :]
    cs, sn = cos[None, :, None], sin[None, :, None]
    out = jnp.stack([x1 * cs - x2 * sn, x2 * cs + x1 * sn], axis=-2)
    return out.reshape(B, N, H, R).astype(x.dtype)


def block_attention(q, k, v, scale):
    B, Nq = q.shape[0], q.shape[1]
    nb = Nq // Q_BLOCK
    qb = q.reshape(B, nb, Q_BLOCK, *q.shape[2:]).swapaxes(0, 1)

    def one_block(qblk):
        s = jnp.einsum('bqhgd,bkhd->bhgqk', qblk, k, preferred_element_type=F32) * scale
        p = jax.nn.softmax(s, axis=-1)
        return jnp.einsum('bhgqk,bkhd->bqhgd', p.astype(v.dtype), v)

    o = lax.map(one_block, qb)
    return o.swapaxes(0, 1).reshape(B, Nq, q.shape[2], q.shape[3], v.shape[-1])


def centred_dwconv(x, w, b):
    out = lax.conv_general_dilated(
        x, w[:, None, :].astype(x.dtype), window_strides=(1,),
        padding=[(SSD_CONV // 2, SSD_CONV // 2)],
        dimension_numbers=('NWC', 'WIO', 'NWC'), feature_group_count=x.shape[-1])
    return out + b.astype(x.dtype)


def gla_chunked(q, k, v, logg, s0):
    B, N, H, dk = q.shape
    dv = v.shape[-1]
    C = GLA_CHUNK
    nc = N // C
    qc = q.astype(F32).reshape(B, nc, C, H, dk)
    kc = k.astype(F32).reshape(B, nc, C, H, dk)
    vc = v.astype(F32).reshape(B, nc, C, H, dv)
    b = jnp.cumsum(logg.astype(F32).reshape(B, nc, C, H, dk), axis=2)
    b_last = b[:, :, -1:]
    q_dec = qc * jnp.exp(b)
    k_in = kc * jnp.exp(-b)
    k_out = kc * jnp.exp(b_last - b)
    mask = jnp.tril(jnp.ones((C, C), bool))
    att = jnp.einsum('bnihd,bnjhd->bnhij', q_dec, k_in)
    att = jnp.where(mask, att, 0.0)
    o_intra = jnp.einsum('bnhij,bnjhe->bnihe', att, vc)
    chunk_upd = jnp.einsum('bnjhd,bnjhe->bnhde', k_out, vc)
    chunk_dec = jnp.exp(b_last[:, :, 0])

    def step(s, inp):
        qd, dec, upd = inp
        o = jnp.einsum('bihd,bhde->bihe', qd, s)
        return dec[..., None] * s + upd, o

    s_fin, o_inter = lax.scan(step, s0.astype(F32),
                              (q_dec.swapaxes(0, 1), chunk_dec.swapaxes(0, 1), chunk_upd.swapaxes(0, 1)))
    o = o_intra + o_inter.swapaxes(0, 1)
    return o.reshape(B, N, H, dv), s_fin


def ssd_chunked(x, dt, a, bm, cm, h0):
    B, N, H, P = x.shape
    G, S = bm.shape[2], bm.shape[3]
    R = H // G
    C = SSD_CHUNK
    nc = N // C
    xc = (x.astype(F32) * dt[..., None]).reshape(B, nc, C, G, R, P)
    cum = jnp.cumsum(a.reshape(B, nc, C, G, R), axis=2)
    bc = bm.astype(F32).reshape(B, nc, C, G, S)
    cc = cm.astype(F32).reshape(B, nc, C, G, S)
    causal = jnp.tril(jnp.ones((C, C), bool))[:, :, None, None]
    seg = cum[:, :, :, None] - cum[:, :, None, :]
    decay_ij = jnp.exp(jnp.where(causal, seg, -jnp.inf))
    scores = jnp.einsum('bnigs,bnjgs->bnijg', cc, bc)
    y_intra = jnp.einsum('bnijg,bnijgr,bnjgrp->bnigrp', scores, decay_ij, xc)
    decay_out = jnp.exp(cum[:, :, -1:] - cum)
    chunk_state = jnp.einsum('bnjgs,bnjgr,bnjgrp->bngrps', bc, decay_out, xc)
    chunk_decay = jnp.exp(cum[:, :, -1])

    def step(h, inp):
        c_n, cum_n, dec_n, st_n = inp
        y = jnp.einsum('bigs,bgrps->bigrp', c_n, h) * jnp.exp(cum_n)[..., None]
        return dec_n[..., None, None] * h + st_n, y

    h_fin, y_inter = lax.scan(step, h0.astype(F32).reshape(B, G, R, P, S),
                              (cc.swapaxes(0, 1), cum.swapaxes(0, 1), chunk_decay.swapaxes(0, 1), chunk_state.swapaxes(0, 1)))
    y = y_intra + y_inter.swapaxes(0, 1)
    return y.reshape(B, N, H, P), h_fin.reshape(B, H, P, S)


def flip(t):
    return jnp.flip(t, axis=1)


def trunk_layer(x, mod, p, cache):
    is_ctx = cache is None
    B, N, _ = x.shape
    dt_x = x.dtype
    shift, scale, gate = jnp.split(mod, 3, axis=-1)
    h = rms_norm(x, p['norm_pre']) * (1 + scale) + shift
    u = h @ p['w_in']
    (gq, gk, gv, ggate, lq, lk, lv, lglr, lgate, mcq, mckv, mkr, mgate, sz, sxbc, sdt) = jnp.split(u, PROJ_SPLITS, axis=-1)
    if not is_ctx:
        k_gqa_c, v_gqa_c, ckv_c, kr_c, s_gla_c, s_ssd_c = cache
        cos_h, sin_h = axial_rope_angles(N, HEAD_DIM)
        cos_r, sin_r = axial_rope_angles(N, MLA_ROPE)

    qa = rms_norm(gq.reshape(B, N, GQA_HEADS, HEAD_DIM), p['gqa_q_norm'])
    ka = rms_norm(gk.reshape(B, N, GQA_KV_HEADS, HEAD_DIM), p['gqa_k_norm'])
    va = gv.reshape(B, N, GQA_KV_HEADS, HEAD_DIM)
    if is_ctx:
        qa_use, ka_all, va_all = qa, ka, va
    else:
        qa_use = apply_axial_rope(qa, cos_h, sin_h)
        ka_all = jnp.concatenate([k_gqa_c.astype(dt_x), apply_axial_rope(ka, cos_h, sin_h)], axis=1)
        va_all = jnp.concatenate([v_gqa_c.astype(dt_x), va], axis=1)
    o_a = block_attention(qa_use.reshape(B, N, GQA_KV_HEADS, GQA_HEADS // GQA_KV_HEADS, HEAD_DIM),
                          ka_all, va_all, HEAD_DIM ** -0.5).reshape(B, N, BRANCH)
    o_a = o_a * jax.nn.silu(ggate)

    qb = lq.reshape(B, N, GLA_HEADS, GLA_DK) * (GLA_DK ** -0.5)
    kb = lk.reshape(B, N, GLA_HEADS, GLA_DK)
    vb = lv.reshape(B, N, GLA_HEADS, GLA_DV)
    glr = lglr.reshape(B, N, 2, GLA_LR).astype(F32)
    logg = jax.nn.log_sigmoid(jnp.einsum('bndr,dre->bnde', glr, p['gla_w_gate'].astype(F32))
                              + p['gla_b_gate'].astype(F32)) / GLA_TAU
    logg = logg.reshape(B, N, 2, GLA_HEADS, GLA_DK)
    s_gla0 = jnp.zeros((B, 2, GLA_HEADS, GLA_DK, GLA_DV), F32) if is_ctx else s_gla_c
    o_f, s_f = gla_chunked(qb, kb, vb, logg[:, :, 0], s_gla0[:, 0])
    o_bw, s_bw = gla_chunked(flip(qb), flip(kb), flip(vb), flip(logg[:, :, 1]), s_gla0[:, 1])
    o_gla = rms_norm(o_f + flip(o_bw), p['gla_norm']).reshape(B, N, BRANCH).astype(dt_x)
    o_b = o_gla * jax.nn.silu(lgate)

    cq = rms_norm(mcq, p['mla_q_norm'])
    qm = (cq @ p['mla_w_uq']).reshape(B, N, MLA_HEADS, MLA_NOPE + MLA_ROPE)
    q_nope, q_rope = qm[..., :MLA_NOPE], qm[..., MLA_NOPE:]
    ckv = rms_norm(mckv, p['mla_kv_norm'])
    if is_ctx:
        ckv_all, kr_all = ckv, mkr
    else:
        q_rope = apply_axial_rope(q_rope, cos_r, sin_r)
        kr_lat = apply_axial_rope(mkr[:, :, None, :], cos_r, sin_r)[:, :, 0]
        ckv_all = jnp.concatenate([ckv_c.astype(dt_x), ckv], axis=1)
        kr_all = jnp.concatenate([kr_c.astype(dt_x), kr_lat], axis=1)
    nk = ckv_all.shape[1]
    kvm = (ckv_all @ p['mla_w_ukv']).reshape(B, nk, MLA_HEADS, MLA_NOPE + MLA_V)
    k_nope, v_m = kvm[..., :MLA_NOPE], kvm[..., MLA_NOPE:]
    k_m = jnp.concatenate([k_nope, jnp.broadcast_to(kr_all[:, :, None, :], (B, nk, MLA_HEADS, MLA_ROPE))], axis=-1)
    q_m = jnp.concatenate([q_nope, q_rope], axis=-1)[:, :, :, None, :]
    o_c = block_attention(q_m, k_m, v_m, (MLA_NOPE + MLA_ROPE) ** -0.5).reshape(B, N, BRANCH)
    o_c = o_c * jax.nn.silu(mgate)

    xbc = jax.nn.silu(centred_dwconv(sxbc, p['ssd_conv_w'], p['ssd_conv_b']))
    xs, bs, cs = jnp.split(xbc, [BRANCH, BRANCH + SSD_GROUPS * SSD_STATE], axis=-1)
    xs = xs.reshape(B, N, SSD_HEADS, SSD_HEAD_DIM)
    bs = bs.reshape(B, N, SSD_GROUPS, SSD_STATE)
    cs = cs.reshape(B, N, SSD_GROUPS, SSD_STATE)
    dt = jax.nn.softplus(sdt.reshape(B, N, 2, SSD_HEADS).astype(F32) + p['ssd_dt_bias'].astype(F32))
    a = dt * (-jnp.exp(p['ssd_a_log'].astype(F32)))
    h_ssd0 = jnp.zeros((B, 2, SSD_HEADS, SSD_HEAD_DIM, SSD_STATE), F32) if is_ctx else s_ssd_c
    y_f, h_f = ssd_chunked(xs, dt[:, :, 0], a[:, :, 0], bs, cs, h_ssd0[:, 0])
    y_bw, h_bw = ssd_chunked(flip(xs), flip(dt[:, :, 1]), flip(a[:, :, 1]), flip(bs), flip(cs), h_ssd0[:, 1])
    y_ssd = y_f + flip(y_bw) + p['ssd_d'].astype(F32)[:, None] * xs.astype(F32)
    o_d = rms_norm(y_ssd.reshape(B, N, BRANCH) * jax.nn.silu(sz.astype(F32)), p['ssd_norm']).astype(dt_x)

    o = jnp.concatenate([o_a, o_b, o_c, o_d], axis=-1) @ p['w_out']
    y = x + gate * rms_norm(o, p['norm_post'])
    if is_ctx:
        gla_state = jnp.stack([s_f, s_bw], axis=1).astype(dt_x)
        ssd_state = jnp.stack([h_f, h_bw], axis=1).astype(dt_x)
        return y, (ka, va, ckv, mkr, gla_state, ssd_state)
    return y


def setup_inputs(seed: int = 0) -> dict:
    key = jax.random.key(seed)
    ks = jax.random.split(key, 32)

    def nrm(k, shape, s):
        return jax.random.normal(k, shape, F32) * s

    def gain(k, shape):
        return 1.0 + 0.05 * jax.random.normal(k, shape, F32)

    dt0 = jnp.exp(jax.random.uniform(ks[28], (DEPTH, 2, SSD_HEADS), F32, math.log(1e-3), math.log(1e-1)))
    return {
        "x_prompt": nrm(ks[0], (BATCH, SEQ, D_MODEL), 1.0),
        "x_sample": nrm(ks[1], (DEC_BATCH, DEC_SEQ, D_MODEL), 1.0),
        "c": nrm(ks[2], (DEC_BATCH, D_MODEL), 1.0),
        "cache_gqa_k": nrm(ks[3], (DEC_BATCH, DEPTH, PAST_LEN, GQA_KV_HEADS, HEAD_DIM), 1.0),
        "cache_gqa_v": nrm(ks[4], (DEC_BATCH, DEPTH, PAST_LEN, GQA_KV_HEADS, HEAD_DIM), 1.0),
        "cache_mla_ckv": nrm(ks[5], (DEC_BATCH, DEPTH, PAST_LEN, MLA_KV_RANK), 1.0),
        "cache_mla_krope": nrm(ks[6], (DEC_BATCH, DEPTH, PAST_LEN, MLA_ROPE), 1.0),
        "state_gla": nrm(ks[7], (DEC_BATCH, DEPTH, 2, GLA_HEADS, GLA_DK, GLA_DV), 1.0),
        "state_ssd": nrm(ks[8], (DEC_BATCH, DEPTH, 2, SSD_HEADS, SSD_HEAD_DIM, SSD_STATE), 0.5),
        "c_ctx": nrm(ks[9], (D_MODEL,), 1.0),
        "w_ada": nrm(ks[10], (DEPTH, D_MODEL, 3 * D_MODEL), 0.5 * D_MODEL ** -0.5),
        "b_ada": nrm(ks[11], (DEPTH, 3 * D_MODEL), 0.02),
        "norm_pre": gain(ks[12], (DEPTH, D_MODEL)),
        "norm_post": gain(ks[13], (DEPTH, D_MODEL)),
        "w_in": nrm(ks[14], (DEPTH, D_MODEL, PROJ_DIM), D_MODEL ** -0.5),
        "w_out": nrm(ks[15], (DEPTH, D_MIX, D_MODEL), D_MIX ** -0.5),
        "gqa_q_norm": gain(ks[16], (DEPTH, HEAD_DIM)),
        "gqa_k_norm": gain(ks[17], (DEPTH, HEAD_DIM)),
        "gla_w_gate": nrm(ks[18], (DEPTH, 2, GLA_LR, GLA_HEADS * GLA_DK), GLA_LR ** -0.5),
        "gla_b_gate": nrm(ks[19], (DEPTH, 2, GLA_HEADS * GLA_DK), 0.1),
        "gla_norm": gain(ks[20], (DEPTH, GLA_DV)),
        "mla_q_norm": gain(ks[21], (DEPTH, MLA_Q_RANK)),
        "mla_kv_norm": gain(ks[22], (DEPTH, MLA_KV_RANK)),
        "mla_w_uq": nrm(ks[23], (DEPTH, MLA_Q_RANK, MLA_HEADS * (MLA_NOPE + MLA_ROPE)), MLA_Q_RANK ** -0.5),
        "mla_w_ukv": nrm(ks[24], (DEPTH, MLA_KV_RANK, MLA_HEADS * (MLA_NOPE + MLA_V)), MLA_KV_RANK ** -0.5),
        "ssd_conv_w": nrm(ks[25], (DEPTH, SSD_CONV, SSD_CONV_CH), SSD_CONV ** -0.5),
        "ssd_conv_b": nrm(ks[26], (DEPTH, SSD_CONV_CH), 0.02),
        "ssd_dt_bias": dt0 + jnp.log(-jnp.expm1(-dt0)),
        "ssd_a_log": jnp.log(jax.random.uniform(ks[27], (DEPTH, 2, SSD_HEADS), F32, 1.0, 16.0)),
        "ssd_d": 1.0 + 0.1 * jax.random.normal(ks[29], (DEPTH, SSD_HEADS), F32),
        "ssd_norm": gain(ks[30], (DEPTH, BRANCH)),
    }


def reference(x_prompt, x_sample, c, cache_gqa_k, cache_gqa_v, cache_mla_ckv, cache_mla_krope, state_gla, state_ssd,
              c_ctx, w_ada, b_ada, norm_pre, norm_post, w_in, w_out, gqa_q_norm, gqa_k_norm, gla_w_gate, gla_b_gate,
              gla_norm, mla_q_norm, mla_kv_norm, mla_w_uq, mla_w_ukv, ssd_conv_w, ssd_conv_b, ssd_dt_bias, ssd_a_log,
              ssd_d, ssd_norm):
    def layer_params(l):
        return {
            'norm_pre': norm_pre[l], 'norm_post': norm_post[l], 'w_in': w_in[l], 'w_out': w_out[l],
            'gqa_q_norm': gqa_q_norm[l], 'gqa_k_norm': gqa_k_norm[l],
            'gla_w_gate': gla_w_gate[l], 'gla_b_gate': gla_b_gate[l], 'gla_norm': gla_norm[l],
            'mla_q_norm': mla_q_norm[l], 'mla_kv_norm': mla_kv_norm[l], 'mla_w_uq': mla_w_uq[l], 'mla_w_ukv': mla_w_ukv[l],
            'ssd_conv_w': ssd_conv_w[l], 'ssd_conv_b': ssd_conv_b[l], 'ssd_dt_bias': ssd_dt_bias[l],
            'ssd_a_log': ssd_a_log[l], 'ssd_d': ssd_d[l], 'ssd_norm': ssd_norm[l],
        }

    y_prompt = x_prompt
    ctx_out = []
    for l in range(DEPTH):
        mod_ctx = jax.nn.silu(c_ctx) @ w_ada[l] + b_ada[l]
        y_prompt, ctx_t = trunk_layer(y_prompt, mod_ctx, layer_params(l), None)
        ctx_out.append(ctx_t)
    new_gqa_k = jnp.stack([t[0] for t in ctx_out], axis=1)
    new_gqa_v = jnp.stack([t[1] for t in ctx_out], axis=1)
    new_mla_ckv = jnp.stack([t[2] for t in ctx_out], axis=1)
    new_mla_krope = jnp.stack([t[3] for t in ctx_out], axis=1)
    new_state_gla = jnp.stack([t[4] for t in ctx_out], axis=1)
    new_state_ssd = jnp.stack([t[5] for t in ctx_out], axis=1)

    y_sample = x_sample
    for l in range(DEPTH):
        mod_lat = (jax.nn.silu(c) @ w_ada[l] + b_ada[l])[:, None, :]
        cache_l = (cache_gqa_k[:, l], cache_gqa_v[:, l], cache_mla_ckv[:, l], cache_mla_krope[:, l],
                   state_gla[:, l], state_ssd[:, l])
        y_sample = trunk_layer(y_sample, mod_lat, layer_params(l), cache_l)

    return (y_prompt, y_sample, new_gqa_k, new_gqa_v, new_mla_ckv, new_mla_krope, new_state_gla, new_state_ssd)
```

```cpp
#include <hip/hip_runtime.h>
#include <hip/hip_cooperative_groups.h>
#include <cstdio>
namespace cg = cooperative_groups;

typedef unsigned short u16;
using bf16x8 = __attribute__((ext_vector_type(8))) short;
using f32x4 = __attribute__((ext_vector_type(4))) float;
using u32x4 = __attribute__((ext_vector_type(4))) unsigned;
#define DI __device__ __forceinline__

static constexpr size_t WS_MOD = 0;
static constexpr size_t WS_BAR = 512ull << 10;
static constexpr size_t WS_WINT = 1ull << 20;
static constexpr size_t WS_WOUTT = WS_WINT + 2ull * 3072 * 1024 * 2;
static constexpr size_t WS_WUQT = WS_WOUTT + 2ull * 1024 * 1024 * 2;
static constexpr size_t WS_WUKVT = WS_WUQT + 2ull * 384 * 192 * 2;
static constexpr size_t WS_H = WS_WUKVT + 2ull * 512 * 128 * 2;
static constexpr size_t WS_U = WS_H + 12288ull * 1024 * 2;
static constexpr size_t WS_SIDE = WS_U + 12288ull * 3072 * 2;
static constexpr size_t WS_QG = WS_SIDE + 12288ull * 40 * 4;
static constexpr size_t WS_KG = WS_QG + 12288ull * 256 * 2;
static constexpr size_t WS_VGT = WS_KG + 13312ull * 128 * 2;
static constexpr size_t WS_QM = WS_VGT + 13312ull * 128 * 2;
static constexpr size_t WS_KM = WS_QM + 12288ull * 384 * 2;
static constexpr size_t WS_VMT = WS_KM + 13312ull * 384 * 2;
static constexpr size_t WS_XBC = WS_VMT + 13312ull * 256 * 2;
static constexpr size_t WS_GUPD = WS_XBC + 12288ull * 512 * 2;
static constexpr size_t WS_GDEC = WS_GUPD + 192ull * 2 * 4 * 2048 * 4;
static constexpr size_t WS_SST = WS_GDEC + 192ull * 2 * 4 * 32 * 4;
static constexpr size_t WS_SDEC = WS_SST + 192ull * 2 * 4 * 4096 * 4;
static constexpr size_t WS_SSQ = WS_SDEC + 192ull * 8 * 4;
static constexpr size_t WS_CBG = WS_SSQ + 12288ull * 2 * 4;
static constexpr size_t WS_END = WS_CBG + 768ull * 4160 * 4;

static constexpr int OUT_GK = 12582912;
static constexpr int OUT_GV = OUT_GK + 2097152;
static constexpr int OUT_CKV = OUT_GV + 2097152;
static constexpr int OUT_KR = OUT_CKV + 2097152;
static constexpr int OUT_SG = OUT_KR + 524288;
static constexpr int OUT_SS = OUT_SG + 1048576;

static constexpr int SMEM_BYTES = 73728;
#define EPS 1e-6f
#define QSC_G (0.125f * 1.44269504089f)

#define XB_TMO      128
#define XB_XCNT(j)  (256  + 64 * (j))
#define XB_XSUB(j)  (1280 + 64 * (j))
#define XB_XGEN(j)  (2304 + 64 * (j))
#define XB_TOP      3328
#define XB_TOPGEN   3392
#define XCD_BAR_WORDS 3456
#define XB_SPIN_CAP (1u << 18)
#define LAS __attribute__((address_space(3)))

__device__ __forceinline__ unsigned xb_ld(unsigned* p)              { return __hip_atomic_load(p, __ATOMIC_RELAXED, __HIP_MEMORY_SCOPE_AGENT); }
__device__ __forceinline__ unsigned xb_add(unsigned* p, unsigned v) { return __hip_atomic_fetch_add(p, v, __ATOMIC_RELAXED, __HIP_MEMORY_SCOPE_AGENT); }
__device__ __forceinline__ unsigned xb_xcc_id() { return (unsigned)__builtin_amdgcn_s_getreg((3 << 11) | 20) & 0xFu; }
#define XB_SPIN(cond, bar) do { unsigned _sp = 0; while (cond) { __builtin_amdgcn_s_sleep(1); \
    if ((++_sp & 255u) == 0u) { if (xb_ld(&(bar)[XB_TMO])) break; if (_sp > XB_SPIN_CAP) { atomicAdd(&(bar)[XB_TMO], 1u); break; } } } } while (0)

struct XcdBarrier {
    unsigned* bar; unsigned x;
    volatile LAS unsigned* st;
};

__device__ __forceinline__ XcdBarrier xcd_barrier_post(unsigned* bar, volatile LAS unsigned* st) {
    XcdBarrier b; b.bar = bar; b.x = xb_xcc_id(); b.st = st;
    if (threadIdx.x == 0) (void)xb_add(&bar[XB_XCNT(b.x)], 1u);
    return b;
}
__device__ __forceinline__ void xcd_barrier_complete(unsigned* bar, unsigned x, unsigned& nloc, unsigned& nx) {
    const unsigned G = gridDim.x * gridDim.y * gridDim.z;
    unsigned sum, cnt, mine, sp = 0u;
    for (;;) {
        sum = 0u; cnt = 0u; mine = 0u;
#pragma unroll
        for (unsigned j = 0; j < 16; ++j) { const unsigned c = xb_ld(&bar[XB_XCNT(j)]); sum += c; cnt += (c > 0u) ? 1u : 0u; mine = (j == x) ? c : mine; }
        if (sum == G) break;
        __builtin_amdgcn_s_sleep(1);
        if ((++sp & 255u) == 0u) { if (xb_ld(&bar[XB_TMO])) break; if (sp > XB_SPIN_CAP) { atomicAdd(&bar[XB_TMO], 1u); break; } }
    }
    nloc = mine > 0u ? mine : 1u; nx = cnt > 0u ? cnt : 1u;
}

__device__ __forceinline__ void xcd_barrier(const XcdBarrier& b) {
    asm volatile("s_waitcnt vmcnt(0)" ::: "memory");
    __syncthreads();
    if (threadIdx.x == 0) {
        unsigned* bar = b.bar;
        __builtin_amdgcn_s_waitcnt(0);
        unsigned nloc = b.st[0], nx = b.st[1];
        if (nloc == 0u) { xcd_barrier_complete(bar, b.x, nloc, nx); b.st[0] = nloc; b.st[1] = nx; }
        const unsigned old = xb_add(&bar[XB_XSUB(b.x)], 1u);
        const unsigned gen = old / nloc;
        if (old + 1u == (gen + 1u) * nloc) {
            __builtin_amdgcn_fence(__ATOMIC_RELEASE, "agent");
            asm volatile("s_waitcnt vmcnt(0)" ::: "memory");
            const unsigned og = xb_add(&bar[XB_TOP], 1u);
            const unsigned tg = og / nx;
            if (og + 1u == (tg + 1u) * nx) xb_add(&bar[XB_TOPGEN], 1u);
            else XB_SPIN(xb_ld(&bar[XB_TOPGEN]) == tg, bar);
            __builtin_amdgcn_fence(__ATOMIC_ACQUIRE, "agent");
            xb_add(&bar[XB_XGEN(b.x)], 1u);
            asm volatile("s_waitcnt vmcnt(0)" ::: "memory");
        } else {
            XB_SPIN(xb_ld(&bar[XB_XGEN(b.x)]) == gen, bar);
            __builtin_amdgcn_fence(__ATOMIC_ACQUIRE, "agent");
            asm volatile("s_waitcnt vmcnt(0)" ::: "memory");
        }
    }
    __syncthreads();
}


struct P {
  const float* in[31];
  float* out;
  char* ws;
};

DI int otid() { int t = threadIdx.x; asm volatile("" : "+v"(t)); return t; }
typedef float f32x2_t __attribute__((ext_vector_type(2)));
typedef __bf16 bf16x2_t __attribute__((ext_vector_type(2)));
DI u16 f2bf(float x) { return __builtin_bit_cast(u16, (__bf16)x); }
DI float bf2f(u16 v) { return __uint_as_float(((unsigned)v) << 16); }
DI unsigned pack2(float a, float b) { f32x2_t v = {a, b}; return __builtin_bit_cast(unsigned, __builtin_convertvector(v, bf16x2_t)); }
DI float lo2f(unsigned u) { return __uint_as_float(u << 16); }
DI float hi2f(unsigned u) { return __uint_as_float(u & 0xffff0000u); }
DI f32x4 mfma(bf16x8 a, bf16x8 b, f32x4 c) { return __builtin_amdgcn_mfma_f32_16x16x32_bf16(a, b, c, 0, 0, 0); }
DI bf16x8 ldfrag(const u16* ptr) { return *(const bf16x8*)ptr; }
DI float4 ntload4(const float4* ptr) { f32x4 v = __builtin_nontemporal_load((const f32x4*)ptr); return make_float4(v[0], v[1], v[2], v[3]); }
DI void ntstore4(float4* ptr, float4 v) { f32x4 t = {v.x, v.y, v.z, v.w}; __builtin_nontemporal_store(t, (f32x4*)ptr); }
DI float silu(float x) { return x / (1.f + __expf(-x)); }
DI void st4bf(u16* dst, float a, float b, float c, float d) { uint2 v; v.x = pack2(a, b); v.y = pack2(c, d); *(uint2*)dst = v; }
DI void ld4bf(const u16* src, float* o) { uint2 v = *(const uint2*)src; o[0] = lo2f(v.x); o[1] = hi2f(v.x); o[2] = lo2f(v.y); o[3] = hi2f(v.y); }
DI void ld8bf(const u16* src, float* o) { uint4 v = *(const uint4*)src; o[0] = lo2f(v.x); o[1] = hi2f(v.x); o[2] = lo2f(v.y); o[3] = hi2f(v.y); o[4] = lo2f(v.z); o[5] = hi2f(v.z); o[6] = lo2f(v.w); o[7] = hi2f(v.w); }
DI float wave_sum(float v) { for (int o = 32; o > 0; o >>= 1) v += __shfl_xor(v, o); return v; }
DI float grp16_sum(float v) { v += __shfl_xor(v, 1); v += __shfl_xor(v, 2); v += __shfl_xor(v, 4); v += __shfl_xor(v, 8); return v; }

DI float xmax16(float v) { auto r = __builtin_amdgcn_permlane16_swap(__float_as_uint(v), __float_as_uint(v), false, false); return fmaxf(__uint_as_float(r[0]), __uint_as_float(r[1])); }
DI float xmax32(float v) { auto r = __builtin_amdgcn_permlane32_swap(__float_as_uint(v), __float_as_uint(v), false, false); return fmaxf(__uint_as_float(r[0]), __uint_as_float(r[1])); }
DI float xsum16(float v) { auto r = __builtin_amdgcn_permlane16_swap(__float_as_uint(v), __float_as_uint(v), false, false); return __uint_as_float(r[0]) + __uint_as_float(r[1]); }
DI float xsum32(float v) { auto r = __builtin_amdgcn_permlane32_swap(__float_as_uint(v), __float_as_uint(v), false, false); return __uint_as_float(r[0]) + __uint_as_float(r[1]); }

DI float wave_incl_scan(float v, int lane) {
#pragma unroll
  for (int o = 1; o < 64; o <<= 1) { const float t = __shfl_up(v, o); if (lane >= o) v += t; }
  return v;
}

struct TI { int t0, n0, N, isctx, b, kvoff, nk, kvrow0, c, nc; };
DI TI tile_info(int tt) {
  TI t; t.t0 = tt * 64;
  if (tt < 128) { int seq = tt >> 2; t.n0 = (tt & 3) * 64; t.N = 256; t.isctx = 1; t.b = seq; t.kvoff = seq * 256; t.nk = 256; t.kvrow0 = t.kvoff + t.n0; }
  else { int q = tt - 128; t.b = q >> 5; t.n0 = (q & 31) * 64; t.N = 2048; t.isctx = 0; t.kvoff = 8192 + t.b * 2560; t.nk = 2560; t.kvrow0 = t.kvoff + 512 + t.n0; }
  t.c = t.n0 >> 6; t.nc = t.N >> 6;
  return t;
}

DI void p0_mod(const P& p, int job, char* smem) {
  float* sl = (float*)smem; float* red = sl + 3072;
  const int tid = otid();
#pragma unroll
  for (int i = 0; i < 12; ++i) {
    const int e = tid + 256 * i; const int cnd = e >> 10, k = e & 1023;
    const float v = cnd == 0 ? p.in[9][k] : p.in[2][(cnd - 1) * 1024 + k];
    sl[e] = silu(v);
  }
  __syncthreads();
  const int l = job / 192, c0 = (job % 192) * 16;
  const int ks = tid >> 2, cq = tid & 3;
  const float* w = p.in[10] + (size_t)l * 1024 * 3072 + c0 + cq * 4;
  f32x4 a0 = {0.f, 0.f, 0.f, 0.f}, a1 = a0, a2 = a0;
#pragma unroll
  for (int kk = 0; kk < 16; ++kk) {
    const int k = ks * 16 + kk;
    const f32x4 wv = __builtin_nontemporal_load((const f32x4*)(w + (size_t)k * 3072));
    a0 += wv * sl[k]; a1 += wv * sl[1024 + k]; a2 += wv * sl[2048 + k];
  }
  *(f32x4*)(red + (ks * 3 + 0) * 16 + cq * 4) = a0; *(f32x4*)(red + (ks * 3 + 1) * 16 + cq * 4) = a1; *(f32x4*)(red + (ks * 3 + 2) * 16 + cq * 4) = a2;
  __syncthreads();
  if (tid < 48) {
    const int cnd = tid >> 4, c2 = tid & 15; float s2 = 0;
#pragma unroll 8
    for (int k2 = 0; k2 < 64; ++k2) s2 += red[(k2 * 3 + cnd) * 16 + c2];
    s2 += p.in[11][l * 3072 + c0 + c2];
    ((float*)(p.ws + WS_MOD))[(l * 3 + cnd) * 3072 + c0 + c2] = s2;
  }
  __syncthreads();
}

DI void p0_transpose(const float* src, int K, int N, u16* dst, int tk, int tn, char* smem) {
  float* tile = (float*)smem;
  const int tid = otid(); const int k0 = tk * 64, n0 = tn * 64;
  f32x4 v[4];
#pragma unroll
  for (int i = 0; i < 4; ++i) {
    const int k = i * 16 + (tid >> 4), n = (tid & 15) * 4;
    v[i] = (n0 + n < N) ? __builtin_nontemporal_load((const f32x4*)(src + (size_t)(k0 + k) * N + n0 + n)) : (f32x4){0.f, 0.f, 0.f, 0.f};
  }
#pragma unroll
  for (int i = 0; i < 4; ++i) {
    const int k = i * 16 + (tid >> 4), n = (tid & 15) * 4;
    tile[k * 65 + n] = v[i][0]; tile[k * 65 + n + 1] = v[i][1]; tile[k * 65 + n + 2] = v[i][2]; tile[k * 65 + n + 3] = v[i][3];
  }
  __syncthreads();
  {
    const int n = tid >> 2, kq = (tid & 3) * 16;
    u32x4 o0, o1;
#pragma unroll
    for (int e = 0; e < 4; ++e) {
      o0[e] = pack2(tile[(kq + 2 * e) * 65 + n], tile[(kq + 2 * e + 1) * 65 + n]);
      o1[e] = pack2(tile[(kq + 8 + 2 * e) * 65 + n], tile[(kq + 8 + 2 * e + 1) * 65 + n]);
    }
    u16* d = dst + (size_t)(n0 + n) * K + k0 + kq;
    *(u32x4*)d = o0; *(u32x4*)(d + 8) = o1;
  }
  __syncthreads();
}

DI void phase0(const P& p, char* smem) {
  for (int job = blockIdx.x; job < 2500; job += gridDim.x) {
    if (job < 384) p0_mod(p, job, smem);
    else if (job < 384 + 1536) { int j = job - 384; int l = j / 768, r = j % 768; p0_transpose(p.in[14] + (size_t)l * 1024 * 2952, 1024, 2952, (u16*)(p.ws + WS_WINT) + (size_t)l * 3072 * 1024, r / 48, r % 48, smem); }
    else if (job < 1920 + 512) { int j = job - 1920; int l = j >> 8, r = j & 255; p0_transpose(p.in[15] + (size_t)l * 1024 * 1024, 1024, 1024, (u16*)(p.ws + WS_WOUTT) + (size_t)l * 1024 * 1024, r >> 4, r & 15, smem); }
    else if (job < 2432 + 36) { int j = job - 2432; int l = j / 18, r = j % 18; p0_transpose(p.in[23] + (size_t)l * 192 * 384, 192, 384, (u16*)(p.ws + WS_WUQT) + (size_t)l * 384 * 192, r / 6, r % 6, smem); }
    else { int j = job - 2468; int l = j >> 4, r = j & 15; p0_transpose(p.in[24] + (size_t)l * 128 * 512, 128, 512, (u16*)(p.ws + WS_WUKVT) + (size_t)l * 512 * 128, r >> 3, r & 7, smem); }
  }
}

DI void phaseA(const P& p, int l) {
  const int tidA = otid();
  const int lane = tidA & 63;
  const int gw = blockIdx.x * 4 + (tidA >> 6), nw = gridDim.x * 4;
  const float* MOD = (const float*)(p.ws + WS_MOD);
  const u16* O = (const u16*)(p.ws + WS_U);
  u16* H = (u16*)(p.ws + WS_H);
  float4 xn[4]; uint2 on[4];
  {
    const int row = gw;
    if (row < 12288) {
      const float* xin = (l <= 1) ? (row < 8192 ? p.in[0] + (size_t)row * 1024 : p.in[1] + (size_t)(row - 8192) * 1024) : p.out + (size_t)row * 1024;
#pragma unroll
      for (int i = 0; i < 4; ++i) { xn[i] = ntload4(((const float4*)xin) + i * 64 + lane); if (l > 0) on[i] = ((const uint2*)(O + (size_t)row * 1024))[i * 64 + lane]; }
    }
  }
  for (int row = gw; row < 12288; row += nw) {
    const int cond = row < 8192 ? 0 : 1 + ((row - 8192) >> 11);
    float4 x[4], o[4];
#pragma unroll
    for (int i = 0; i < 4; ++i) { x[i] = xn[i]; o[i] = make_float4(lo2f(on[i].x), hi2f(on[i].x), lo2f(on[i].y), hi2f(on[i].y)); }
    {
      const int rown = row + nw;
      if (rown < 12288) {
        const float* xin = (l <= 1) ? (rown < 8192 ? p.in[0] + (size_t)rown * 1024 : p.in[1] + (size_t)(rown - 8192) * 1024) : p.out + (size_t)rown * 1024;
#pragma unroll
        for (int i = 0; i < 4; ++i) { xn[i] = ntload4(((const float4*)xin) + i * 64 + lane); if (l > 0) on[i] = ((const uint2*)(O + (size_t)rown * 1024))[i * 64 + lane]; }
      }
    }
    if (l > 0) {
      float ss = 0;
#pragma unroll
      for (int i = 0; i < 4; ++i) ss += o[i].x * o[i].x + o[i].y * o[i].y + o[i].z * o[i].z + o[i].w * o[i].w;
      ss = wave_sum(ss);
      const float rr = rsqrtf(ss * (1.f / 1024.f) + EPS);
      const float* gate = MOD + ((l - 1) * 3 + cond) * 3072 + 2048;
      const float* np = p.in[13] + (l - 1) * 1024;
#pragma unroll
      for (int i = 0; i < 4; ++i) {
        float4 g4 = ((const float4*)gate)[i * 64 + lane], n4 = ((const float4*)np)[i * 64 + lane];
        x[i].x += g4.x * (o[i].x * rr * n4.x); x[i].y += g4.y * (o[i].y * rr * n4.y);
        x[i].z += g4.z * (o[i].z * rr * n4.z); x[i].w += g4.w * (o[i].w * rr * n4.w);
        ntstore4(((float4*)(p.out + (size_t)row * 1024)) + i * 64 + lane, x[i]);
      }
    }
    if (l < 2) {
      float ss = 0;
#pragma unroll
      for (int i = 0; i < 4; ++i) ss += x[i].x * x[i].x + x[i].y * x[i].y + x[i].z * x[i].z + x[i].w * x[i].w;
      ss = wave_sum(ss);
      const float rr = rsqrtf(ss * (1.f / 1024.f) + EPS);
      const float* sh = MOD + (l * 3 + cond) * 3072; const float* sc = sh + 1024;
      const float* np = p.in[12] + l * 1024;
#pragma unroll
      for (int i = 0; i < 4; ++i) {
        float4 s4 = ((const float4*)sh)[i * 64 + lane], c4 = ((const float4*)sc)[i * 64 + lane], n4 = ((const float4*)np)[i * 64 + lane];
        st4bf(H + (size_t)row * 1024 + i * 256 + lane * 4,
              x[i].x * rr * n4.x * (1.f + c4.x) + s4.x, x[i].y * rr * n4.y * (1.f + c4.y) + s4.y,
              x[i].z * rr * n4.z * (1.f + c4.z) + s4.z, x[i].w * rr * n4.w * (1.f + c4.w) + s4.w);
      }
    }
  }
}

template <int MODE>
DI void gemm_tile(const u16* __restrict__ A, const u16* __restrict__ Bt, int mt, int nt, char* cout, float* side, char* smem) {
  u16* As = (u16*)smem;
  const int tid = otid(), lane = tid & 63, w = tid >> 6, r = lane & 15, g = lane >> 4;
  const int wm = w & 1, wn = w >> 1;
  constexpr int TI = MODE == 1 ? 3 : 4;
  constexpr int BMT = TI * 32, WMT = TI * 16;
  const u16* Ag = A + (size_t)(mt * BMT) * 1024;
  const u16* Bg = Bt + (size_t)(nt * 128) * 1024;
  f32x4 acc[4][TI];
#pragma unroll
  for (int i = 0; i < 4; ++i)
#pragma unroll
    for (int j = 0; j < TI; ++j) acc[i][j] = (f32x4){0.f, 0.f, 0.f, 0.f};
  u32x4 ra[2][TI], rb[2][4];
  float rrow[TI];
  if (MODE == 1) {
#pragma unroll
    for (int ti = 0; ti < TI; ++ti) { const float2 q = *(const float2*)(side + (size_t)(mt * BMT + wm * WMT + ti * 16 + r) * 2); rrow[ti] = rsqrtf((q.x + q.y) * (1.f / 256.f) + EPS); }
  }
  const int lrow = tid >> 3, lch = (tid & 7) * 8;
  const int lsw = ((tid & 7) ^ ((lrow >> 1) & 7)) * 8;
  const int rsw = (r >> 1) & 7;
#define G_LOAD(SET, KT) { _Pragma("unroll") for (int i = 0; i < 4; ++i) { if (i < TI) ra[SET][i < TI ? i : 0] = *(const u32x4*)(Ag + (size_t)(lrow + 32 * i) * 1024 + (KT) * 64 + lch); rb[SET][i] = *(const u32x4*)(Bg + (size_t)(lrow + 32 * i) * 1024 + (KT) * 64 + lch); } }
#define G_STORE(SET, BUFI) { u16* as_ = As + (BUFI) * (256 * 64); u16* bs_ = as_ + 128 * 64; _Pragma("unroll") for (int i = 0; i < 4; ++i) { if (i < TI) *(u32x4*)(as_ + (lrow + 32 * i) * 64 + lsw) = ra[SET][i < TI ? i : 0]; *(u32x4*)(bs_ + (lrow + 32 * i) * 64 + lsw) = rb[SET][i]; } }
#define G_COMPUTE(BUFI) { const u16* as_ = As + (BUFI) * (256 * 64); const u16* bs_ = as_ + 128 * 64; \
    _Pragma("unroll") for (int s = 0; s < 2; ++s) { bf16x8 wf[4], xf[TI]; const int co = ((s * 4 + g) ^ rsw) * 8; \
      _Pragma("unroll") for (int i = 0; i < 4; ++i) { wf[i] = ldfrag(bs_ + (wn * 64 + i * 16 + r) * 64 + co); if (i < TI) xf[i < TI ? i : 0] = ldfrag(as_ + (wm * WMT + i * 16 + r) * 64 + co); } \
      _Pragma("unroll") for (int ni = 0; ni < 4; ++ni) _Pragma("unroll") for (int ti = 0; ti < TI; ++ti) acc[ni][ti] = mfma(wf[ni], xf[ti], acc[ni][ti]); } }
  G_LOAD(0, 0)
  G_LOAD(1, 1)
  G_STORE(0, 0)
  __syncthreads();
  for (int kt = 0; kt < 16; kt += 2) {
    if (MODE == 1 && kt == 12) {
#pragma unroll
      for (int ni = 0; ni < 4; ++ni)
#pragma unroll
        for (int ti = 0; ti < TI; ++ti) acc[ni][ti] = acc[ni][ti] * (1.f / rrow[ti]);
    }
    if (kt + 2 < 16) G_LOAD(0, kt + 2)
    G_COMPUTE(0)
    G_STORE(1, 1)
    __syncthreads();
    if (kt + 3 < 16) G_LOAD(1, kt + 3)
    G_COMPUTE(1)
    if (kt + 2 < 16) G_STORE(0, 0)
    __syncthreads();
  }
#undef G_LOAD
#undef G_STORE
#undef G_COMPUTE
  u16* Cs = (u16*)smem;
#pragma unroll
  for (int ni = 0; ni < 4; ++ni)
#pragma unroll
    for (int ti = 0; ti < TI; ++ti) {
      f32x4 v = acc[ni][ti];
      if (MODE == 0) {
        const int tok = mt * BMT + wm * WMT + ti * 16 + r;
        const int n = nt * 128 + wn * 64 + ni * 16 + g * 4;
        if (n >= 1280 && n < 1312) *(float4*)(side + (size_t)tok * 40 + (n - 1280)) = make_float4(v[0], v[1], v[2], v[3]);
        if (n >= 2944 && n < 2952) *(float4*)(side + (size_t)tok * 40 + 32 + (n - 2944)) = make_float4(v[0], v[1], v[2], v[3]);
      } else {
        v = v * rrow[ti];
      }
      st4bf(Cs + (wm * WMT + ti * 16 + r) * 136 + wn * 64 + ni * 16 + g * 4, v[0], v[1], v[2], v[3]);
    }
  __syncthreads();
  {
    constexpr int LDC = MODE == 0 ? 3072 : 1024;
    u16* outp = (u16*)cout + (size_t)(mt * BMT) * LDC + nt * 128;
#pragma unroll
    for (int i = 0; i < TI * 2; ++i) {
      const int idx = tid + 256 * i, row = idx >> 4, chk = idx & 15;
      *(u32x4*)(outp + (size_t)row * LDC + chk * 8) = *(const u32x4*)(Cs + row * 136 + chk * 8);
    }
  }
  __syncthreads();
}

DI void vt_store_tile(const u16* tile, u16* vt_base, int nk, int key0) {
  const int tid = otid(), seg = tid & 7;
#pragma unroll
  for (int it = 0; it < 4; ++it) {
    const int c = it * 32 + (tid >> 3);
    u32x4 o;
#pragma unroll
    for (int e = 0; e < 4; ++e) o[e] = (unsigned)tile[(seg * 8 + 2 * e) * 136 + c] | ((unsigned)tile[(seg * 8 + 2 * e + 1) * 136 + c] << 16);
    *(u32x4*)(vt_base + (size_t)c * nk + key0 + seg * 8) = o;
  }
}

DI void c_gqa(const P& p, int l, int tt, char* smem) {
  const TI ti = tile_info(tt);
  const u16* U = (const u16*)(p.ws + WS_U);
  u16* Qg = (u16*)(p.ws + WS_QG); u16* Kg = (u16*)(p.ws + WS_KG); u16* VgT = (u16*)(p.ws + WS_VGT);
  const int tid = otid(), grp = tid >> 4, li = tid & 15;
  const float* qn = p.in[16] + l * 64; const float* kn = p.in[17] + l * 64;
  for (int itb = 0; itb < 24; itb += 4) {
    uint2 xraw[4];
#pragma unroll
    for (int k = 0; k < 4; ++k) { const int u = (itb + k) * 16 + grp; xraw[k] = *(const uint2*)(U + (size_t)(ti.t0 + u / 6) * 3072 + (u % 6) * 64 + li * 4); }
#pragma unroll
    for (int k = 0; k < 4; ++k) {
      const int u = (itb + k) * 16 + grp; const int tok = u / 6, hh = u % 6;
      const int t = ti.t0 + tok, n = ti.n0 + tok;
      float x[4] = {lo2f(xraw[k].x), hi2f(xraw[k].x), lo2f(xraw[k].y), hi2f(xraw[k].y)};
      float ss = x[0] * x[0] + x[1] * x[1] + x[2] * x[2] + x[3] * x[3];
      ss = grp16_sum(ss);
      const float rr = rsqrtf(ss * (1.f / 64.f) + EPS);
      const float* gn = hh < 4 ? qn : kn;
      float y[4];
#pragma unroll
      for (int i = 0; i < 4; ++i) y[i] = x[i] * rr * gn[li * 4 + i];
      if (hh >= 4 && ti.isctx) *(float4*)(p.out + OUT_GK + ((size_t)((ti.b * 2 + l) * 256 + n) * 2 + (hh - 4)) * 64 + li * 4) = make_float4(y[0], y[1], y[2], y[3]);
      if (!ti.isctx) {
        const int axis = li >> 3, half = (li >> 2) & 1;
        const float pos = (float)(axis == 0 ? (n >> 6) : (n & 63));
#pragma unroll
        for (int i = 0; i < 4; ++i) {
          const int f = (li & 3) * 4 + i;
          const float ang = pos * exp2f(-(float)f * 0.83048202372f);
          const float cs = __cosf(ang), sn = __sinf(ang);
          const float pr = __shfl_xor(y[i], 4);
          y[i] = half == 0 ? y[i] * cs - pr * sn : y[i] * cs + pr * sn;
        }
      }
      if (hh < 4) st4bf(Qg + (size_t)t * 256 + hh * 64 + li * 4, y[0] * QSC_G, y[1] * QSC_G, y[2] * QSC_G, y[3] * QSC_G);
      else st4bf(Kg + (size_t)(ti.kvrow0 + tok) * 128 + (hh - 4) * 64 + li * 4, y[0], y[1], y[2], y[3]);
    }
  }
  {
    u16* tile = (u16*)smem;
    const int tok = tid >> 2, cq = tid & 3; const int t = ti.t0 + tok, n = ti.n0 + tok;
    u32x4 vraw[4];
#pragma unroll
    for (int j4 = 0; j4 < 4; ++j4) vraw[j4] = *(const u32x4*)(U + (size_t)t * 3072 + 384 + cq * 32 + j4 * 8);
#pragma unroll
    for (int j4 = 0; j4 < 4; ++j4) {
      *(u32x4*)(tile + tok * 136 + cq * 32 + j4 * 8) = vraw[j4];
      if (ti.isctx) {
        float* o = p.out + OUT_GV + (size_t)((ti.b * 2 + l) * 256 + n) * 128 + cq * 32 + j4 * 8;
        *(float4*)o = make_float4(lo2f(vraw[j4][0]), hi2f(vraw[j4][0]), lo2f(vraw[j4][1]), hi2f(vraw[j4][1]));
        *(float4*)(o + 4) = make_float4(lo2f(vraw[j4][2]), hi2f(vraw[j4][2]), lo2f(vraw[j4][3]), hi2f(vraw[j4][3]));
      }
    }
    __syncthreads();
    vt_store_tile(tile, VgT + (size_t)ti.kvoff * 128, ti.nk, ti.kvrow0 - ti.kvoff);
    __syncthreads();
  }
}

DI void mla_kv_up(const u16* Ackv, const u16* __restrict__ WukvT, u16* Km, u16* VmT, int kvrow0, int kvoff, int nk) {
  const int tid = otid(), lane = tid & 63, w = tid >> 6, r = lane & 15, g = lane >> 4;
  const int h = w;
  bf16x8 wn[4];
#pragma unroll
  for (int s = 0; s < 4; ++s) wn[s] = ldfrag(WukvT + (size_t)(h * 128 + r) * 128 + s * 32 + g * 8);
  for (int sub = 0; sub < 8; ++sub) {
    bf16x8 wf[4];
#pragma unroll
    for (int s = 0; s < 4; ++s) wf[s] = wn[s];
    if (sub < 7) {
#pragma unroll
      for (int s = 0; s < 4; ++s) wn[s] = ldfrag(WukvT + (size_t)(h * 128 + (sub + 1) * 16 + r) * 128 + s * 32 + g * 8);
    }
#pragma unroll
    for (int t4 = 0; t4 < 4; ++t4) {
      f32x4 acc = (f32x4){0.f, 0.f, 0.f, 0.f};
      if (sub < 4) {
#pragma unroll
        for (int s = 0; s < 4; ++s) acc = mfma(wf[s], ldfrag(Ackv + (t4 * 16 + r) * 136 + s * 32 + g * 8), acc);
        st4bf(Km + (size_t)(kvrow0 + t4 * 16 + r) * 384 + h * 96 + sub * 16 + g * 4, acc[0], acc[1], acc[2], acc[3]);
      } else {
#pragma unroll
        for (int s = 0; s < 4; ++s) acc = mfma(ldfrag(Ackv + (t4 * 16 + r) * 136 + s * 32 + g * 8), wf[s], acc);
        const int dv = (sub - 4) * 16 + r;
        st4bf(VmT + (size_t)kvoff * 256 + (size_t)(h * 64 + dv) * nk + (kvrow0 - kvoff) + t4 * 16 + g * 4, acc[0], acc[1], acc[2], acc[3]);
      }
    }
  }
}

DI void c_mla_q(const P& p, int l, int tt, char* smem) {
  const TI ti = tile_info(tt);
  const u16* U = (const u16*)(p.ws + WS_U);
  u16* Qm = (u16*)(p.ws + WS_QM);
  u16* Acq = (u16*)smem;
  const int tid = otid(), grp = tid >> 4, li = tid & 15;
  const float* qn = p.in[21] + l * 192;
  {
    uint2 raw[4][3];
#pragma unroll
    for (int it = 0; it < 4; ++it)
#pragma unroll
      for (int k = 0; k < 3; ++k) raw[it][k] = *(const uint2*)(U + (size_t)(ti.t0 + it * 16 + grp) * 3072 + 1568 + li * 12 + k * 4);
#pragma unroll
    for (int it = 0; it < 4; ++it) {
      const int tok = it * 16 + grp;
      float x[12];
#pragma unroll
      for (int k = 0; k < 3; ++k) { x[k * 4] = lo2f(raw[it][k].x); x[k * 4 + 1] = hi2f(raw[it][k].x); x[k * 4 + 2] = lo2f(raw[it][k].y); x[k * 4 + 3] = hi2f(raw[it][k].y); }
      float ss = 0;
#pragma unroll
      for (int i = 0; i < 12; ++i) ss += x[i] * x[i];
      ss = grp16_sum(ss);
      const float rr = rsqrtf(ss * (1.f / 192.f) + EPS);
#pragma unroll
      for (int i = 0; i < 12; i += 4) st4bf(Acq + tok * 200 + li * 12 + i, x[i] * rr * qn[li * 12 + i], x[i + 1] * rr * qn[li * 12 + i + 1], x[i + 2] * rr * qn[li * 12 + i + 2], x[i + 3] * rr * qn[li * 12 + i + 3]);
    }
  }
  __syncthreads();
  {
    const int lane = tid & 63, w = tid >> 6, r = lane & 15, g = lane >> 4;
    const u16* WuqT = (const u16*)(p.ws + WS_WUQT) + (size_t)l * 384 * 192;
    bf16x8 wn[6];
#pragma unroll
    for (int s = 0; s < 6; ++s) wn[s] = ldfrag(WuqT + (size_t)(w * 96 + r) * 192 + s * 32 + g * 8);
    for (int sub = 0; sub < 6; ++sub) {
      bf16x8 wf[6];
#pragma unroll
      for (int s = 0; s < 6; ++s) wf[s] = wn[s];
      if (sub < 5) {
#pragma unroll
        for (int s = 0; s < 6; ++s) wn[s] = ldfrag(WuqT + (size_t)(w * 96 + (sub + 1) * 16 + r) * 192 + s * 32 + g * 8);
      }
#pragma unroll
      for (int t4 = 0; t4 < 4; ++t4) {
        f32x4 acc = (f32x4){0.f, 0.f, 0.f, 0.f};
#pragma unroll
        for (int s = 0; s < 6; ++s) acc = mfma(wf[s], ldfrag(Acq + (t4 * 16 + r) * 200 + s * 32 + g * 8), acc);
        float y[4] = {acc[0], acc[1], acc[2], acc[3]};
        if (sub >= 4 && !ti.isctx) {
          const int n = ti.n0 + t4 * 16 + r;
          const int axis = sub - 4, half = g >> 1;
          const float pos = (float)(axis == 0 ? (n >> 6) : (n & 63));
#pragma unroll
          for (int i = 0; i < 4; ++i) {
            const int f = (g & 1) * 4 + i;
            const float ang = pos * exp2f(-(float)f * 1.66096404744f);
            const float cs = __cosf(ang), sn = __sinf(ang);
            const float pr = __shfl_xor(y[i], 32);
            y[i] = half == 0 ? y[i] * cs - pr * sn : y[i] * cs + pr * sn;
          }
        }
        const float sc = 0.10206207262f * 1.44269504089f;
        st4bf(Qm + (size_t)(ti.t0 + t4 * 16 + r) * 384 + w * 96 + sub * 16 + g * 4, y[0] * sc, y[1] * sc, y[2] * sc, y[3] * sc);
      }
    }
  }
  __syncthreads();
}

DI void c_mla_kv(const P& p, int l, int tt, char* smem) {
  const TI ti = tile_info(tt);
  const u16* U = (const u16*)(p.ws + WS_U);
  u16* Km = (u16*)(p.ws + WS_KM); u16* VmT = (u16*)(p.ws + WS_VMT);
  u16* Ackv = (u16*)smem;
  const int tid = otid(), grp = tid >> 4, li = tid & 15;
  const float* kvn = p.in[22] + l * 128;
  {
    u32x4 rawc[4]; unsigned rawk[4];
#pragma unroll
    for (int it = 0; it < 4; ++it) {
      rawc[it] = *(const u32x4*)(U + (size_t)(ti.t0 + it * 16 + grp) * 3072 + 1760 + li * 8);
      rawk[it] = *(const unsigned*)(U + (size_t)(ti.t0 + it * 16 + grp) * 3072 + 1888 + li * 2);
    }
#pragma unroll
    for (int it = 0; it < 4; ++it) {
      const int tok = it * 16 + grp; const int n = ti.n0 + tok;
      {
        float x[8];
#pragma unroll
        for (int e = 0; e < 4; ++e) { x[e * 2] = lo2f(rawc[it][e]); x[e * 2 + 1] = hi2f(rawc[it][e]); }
        float ss = 0;
#pragma unroll
        for (int i = 0; i < 8; ++i) ss += x[i] * x[i];
        ss = grp16_sum(ss);
        const float rr = rsqrtf(ss * (1.f / 128.f) + EPS);
#pragma unroll
        for (int i = 0; i < 8; ++i) x[i] = x[i] * rr * kvn[li * 8 + i];
        if (ti.isctx) { float* o = p.out + OUT_CKV + (size_t)((ti.b * 2 + l) * 256 + n) * 128 + li * 8; *(float4*)o = make_float4(x[0], x[1], x[2], x[3]); *(float4*)(o + 4) = make_float4(x[4], x[5], x[6], x[7]); }
        st4bf(Ackv + tok * 136 + li * 8, x[0], x[1], x[2], x[3]); st4bf(Ackv + tok * 136 + li * 8 + 4, x[4], x[5], x[6], x[7]);
      }
      {
        float y[2] = {lo2f(rawk[it]), hi2f(rawk[it])};
        if (ti.isctx) *(float2*)(p.out + OUT_KR + (size_t)((ti.b * 2 + l) * 256 + n) * 32 + li * 2) = make_float2(y[0], y[1]);
        else {
          const int axis = li >> 3, half = (li >> 2) & 1;
          const float pos = (float)(axis == 0 ? (n >> 6) : (n & 63));
#pragma unroll
          for (int e = 0; e < 2; ++e) {
            const int f = (li & 3) * 2 + e;
            const float ang = pos * exp2f(-(float)f * 1.66096404744f);
            const float cs = __cosf(ang), sn = __sinf(ang);
            const float pr = __shfl_xor(y[e], 4);
            y[e] = half == 0 ? y[e] * cs - pr * sn : y[e] * cs + pr * sn;
          }
        }
        const unsigned pk = pack2(y[0], y[1]);
#pragma unroll
        for (int h = 0; h < 4; ++h) *(unsigned*)(Km + (size_t)(ti.kvrow0 + tok) * 384 + h * 96 + 64 + li * 2) = pk;
      }
    }
  }
  __syncthreads();
  mla_kv_up(Ackv, (const u16*)(p.ws + WS_WUKVT) + (size_t)l * 512 * 128, Km, VmT, ti.kvrow0, ti.kvoff, ti.nk);
  __syncthreads();
}

DI void c_cache(const P& p, int l, int job, char* smem) {
  const int b = job >> 3, j0 = (job & 7) * 64;
  const int kvoff = 8192 + b * 2560, nk = 2560, kvrow0 = kvoff + j0;
  u16* Kg = (u16*)(p.ws + WS_KG); u16* VgT = (u16*)(p.ws + WS_VGT); u16* Km = (u16*)(p.ws + WS_KM); u16* VmT = (u16*)(p.ws + WS_VMT);
  u16* Ackv = (u16*)smem;
  const int tid = otid(), grp = tid >> 4, li = tid & 15;
  const size_t cbase = (size_t)(b * 2 + l) * 512 + j0;
  for (int it = 0; it < 4; ++it) {
    const int tok = it * 16 + grp;
    const float* src = p.in[5] + (cbase + tok) * 128 + li * 8;
    float4 a = *(const float4*)src, c = *(const float4*)(src + 4);
    st4bf(Ackv + tok * 136 + li * 8, a.x, a.y, a.z, a.w); st4bf(Ackv + tok * 136 + li * 8 + 4, c.x, c.y, c.z, c.w);
    float2 kr = *(const float2*)(p.in[6] + (cbase + tok) * 32 + li * 2);
    const unsigned pk = pack2(kr.x, kr.y);
#pragma unroll
    for (int h = 0; h < 4; ++h) *(unsigned*)(Km + (size_t)(kvrow0 + tok) * 384 + h * 96 + 64 + li * 2) = pk;
  }
  u16* vtile = Ackv + 64 * 136;
#pragma unroll
  for (int i = 0; i < 8; ++i) {
    const int idx = tid + 256 * i, row = idx >> 5, c4 = (idx & 31) * 4;
    const float4 kv = *(const float4*)(p.in[3] + (cbase + row) * 128 + c4);
    st4bf(Kg + (size_t)(kvrow0 + row) * 128 + c4, kv.x, kv.y, kv.z, kv.w);
    const float4 vv = *(const float4*)(p.in[4] + (cbase + row) * 128 + c4);
    st4bf(vtile + row * 136 + c4, vv.x, vv.y, vv.z, vv.w);
  }
  __syncthreads();
  vt_store_tile(vtile, VgT + (size_t)kvoff * 128, nk, j0);
  mla_kv_up(Ackv, (const u16*)(p.ws + WS_WUKVT) + (size_t)l * 512 * 128, Km, VmT, kvrow0, kvoff, nk);
  __syncthreads();
}

DI void gla_logg_cum(const P& p, int l, int t0, int h, float* CB, float* TT) {
  const int tid = otid(), tok = tid >> 2, dsub = tid & 3;
  const float* SIDE = (const float*)(p.ws + WS_SIDE);
  for (int dir = 0; dir < 2; ++dir) {
    const float* gl = SIDE + (size_t)(t0 + tok) * 40 + dir * 16;
    float glr[16];
#pragma unroll
    for (int i = 0; i < 4; ++i) { float4 v = ((const float4*)gl)[i]; glr[i * 4] = v.x; glr[i * 4 + 1] = v.y; glr[i * 4 + 2] = v.z; glr[i * 4 + 3] = v.w; }
    float acc[8];
    const float* bg = p.in[19] + (l * 2 + dir) * 128 + h * 32 + dsub * 8;
#pragma unroll
    for (int e = 0; e < 8; ++e) acc[e] = bg[e];
#pragma unroll
    for (int r = 0; r < 16; ++r) {
      const float* wr = p.in[18] + (size_t)((l * 2 + dir) * 16 + r) * 128 + h * 32 + dsub * 8;
      float4 w0 = *(const float4*)wr, w1 = *(const float4*)(wr + 4);
      acc[0] += glr[r] * w0.x; acc[1] += glr[r] * w0.y; acc[2] += glr[r] * w0.z; acc[3] += glr[r] * w0.w;
      acc[4] += glr[r] * w1.x; acc[5] += glr[r] * w1.y; acc[6] += glr[r] * w1.z; acc[7] += glr[r] * w1.w;
    }
#pragma unroll
    for (int e = 0; e < 8; ++e) {
      const float x = acc[e];
      const float ls = fminf(x, 0.f) - 0.69314718056f * __log2f(1.f + __builtin_amdgcn_exp2f(-1.44269504089f * fabsf(x)));
      CB[(dir * 64 + tok) * 32 + dsub * 8 + e] = ls * (1.f / 16.f);
    }
  }
  __syncthreads();
  {
    const int lane = tid & 63, w = tid >> 6;
#pragma unroll 4
    for (int i = 0; i < 16; ++i) {
      const int col = w * 16 + i, dir = col >> 5, d = col & 31;
      const int j = dir ? 63 - lane : lane;
      float v = CB[(dir * 64 + j) * 32 + d];
      v = wave_incl_scan(v, lane);
      CB[(dir * 64 + j) * 32 + d] = v;
      if (lane == 63) TT[col] = v;
    }
  }
  __syncthreads();
}

DI void c_gla(const P& p, int l, int tt, int h, char* smem) {
  const int t0 = tt * 64;
  float* CB = (float*)smem; float* TT = CB + 4096;
  u16* KoutT = (u16*)(TT + 64); u16* VT = KoutT + 64 * 72;
  const u16* U = (const u16*)(p.ws + WS_U);
  const int tid = otid();
  gla_logg_cum(p, l, t0, h, CB, TT);
  {
    float* dst = (float*)(p.ws + WS_CBG) + (size_t)(tt * 4 + h) * 4160;
#pragma unroll
    for (int i = 0; i < 4; ++i) *(float4*)(dst + (tid + 256 * i) * 4) = *(const float4*)(CB + (tid + 256 * i) * 4);
    if (tid < 16) *(float4*)(dst + 4096 + tid * 4) = *(const float4*)(TT + tid * 4);
  }
  {
    const int tok = tid >> 2, sub = tid & 3;
    float k[8]; ld8bf(U + (size_t)(t0 + tok) * 3072 + 896 + h * 32 + sub * 8, k);
#pragma unroll
    for (int dir = 0; dir < 2; ++dir)
#pragma unroll
      for (int e = 0; e < 8; ++e) { const int d = sub * 8 + e; KoutT[(dir * 32 + d) * 72 + tok] = f2bf(k[e] * __expf(TT[dir * 32 + d] - CB[(dir * 64 + tok) * 32 + d])); }
    const u16* vs = U + (size_t)(t0 + tok) * 3072 + 1024 + h * 64 + sub * 16;
    u32x4 v0 = *(const u32x4*)vs, v1 = *(const u32x4*)(vs + 8);
#pragma unroll
    for (int e = 0; e < 4; ++e) {
      VT[(sub * 16 + e * 2) * 72 + tok] = (u16)(v0[e] & 0xffffu); VT[(sub * 16 + e * 2 + 1) * 72 + tok] = (u16)(v0[e] >> 16);
      VT[(sub * 16 + 8 + e * 2) * 72 + tok] = (u16)(v1[e] & 0xffffu); VT[(sub * 16 + 8 + e * 2 + 1) * 72 + tok] = (u16)(v1[e] >> 16);
    }
  }
  __syncthreads();
  {
    const int lane = tid & 63, w = tid >> 6, r = lane & 15, g = lane >> 4;
    const int dir = w >> 1, dt = w & 1;
    float* UPD = (float*)(p.ws + WS_GUPD) + (size_t)((tt * 2 + dir) * 4 + h) * 2048;
    bf16x8 b0 = ldfrag(KoutT + (dir * 32 + dt * 16 + r) * 72 + g * 8), b1 = ldfrag(KoutT + (dir * 32 + dt * 16 + r) * 72 + 32 + g * 8);
#pragma unroll
    for (int et = 0; et < 4; ++et) {
      f32x4 acc = (f32x4){0.f, 0.f, 0.f, 0.f};
      acc = mfma(ldfrag(VT + (et * 16 + r) * 72 + g * 8), b0, acc);
      acc = mfma(ldfrag(VT + (et * 16 + r) * 72 + 32 + g * 8), b1, acc);
      *(float4*)(UPD + (dt * 16 + r) * 64 + et * 16 + g * 4) = make_float4(acc[0], acc[1], acc[2], acc[3]);
    }
    if (tid < 64) ((float*)(p.ws + WS_GDEC))[((tt * 2 + (tid >> 5)) * 4 + h) * 32 + (tid & 31)] = __expf(TT[tid]);
  }
  __syncthreads();
}

DI float softplus(float x) { return x > 20.f ? x : log1pf(__expf(x)); }

DI void c_ssd(const P& p, int l, int tt, int grp, char* smem) {
  const TI ti = tile_info(tt);
  const int t0 = ti.t0;
  u16* XsT = (u16*)smem;
  u16* BwT = XsT + 128 * 72;
  float* DT = (float*)(BwT + 4 * 64 * 72);
  float* CUM = DT + 256; float* WJ = CUM + 256; float* TOT = WJ + 256;
  const u16* U = (const u16*)(p.ws + WS_U);
  const float* SIDE = (const float*)(p.ws + WS_SIDE);
  u16* XBC = (u16*)(p.ws + WS_XBC);
  const int tid = otid();
  {
    const int tok = tid & 63, combo = tid >> 6, dir = combo >> 1, head = grp * 2 + (combo & 1);
    const float raw = SIDE[(size_t)(t0 + tok) * 40 + 32 + dir * 4 + head] + p.in[27][(l * 2 + dir) * 4 + head];
    const float dt = softplus(raw);
    DT[tid] = dt; CUM[tid] = -__expf(p.in[28][(l * 2 + dir) * 4 + head]) * dt;
  }
  __syncthreads();
  {
    const int lane = tid & 63, w = tid >> 6, dir = w >> 1;
    const int j = dir ? 63 - lane : lane;
    float v = CUM[w * 64 + j];
    v = wave_incl_scan(v, lane);
    CUM[w * 64 + j] = v;
    if (lane == 63) TOT[w] = v;
  }
  __syncthreads();
  WJ[tid] = DT[tid] * __expf(TOT[tid >> 6] - CUM[tid]);
  __syncthreads();
  {
    const int co = tid & 31, tg = tid >> 5;
    int ch;
    if (co < 16) ch = grp * 128 + co * 8; else if (co < 24) ch = 256 + grp * 64 + (co - 16) * 8; else ch = 384 + grp * 64 + (co - 24) * 8;
    const int jb = tg * 8;
    u32x4 xr[12];
#pragma unroll
    for (int w = 0; w < 12; ++w) {
      const int n = ti.n0 + jb + w - 2;
      xr[w] = (n >= 0 && n < ti.N) ? *(const u32x4*)(U + (size_t)(t0 + jb + w - 2) * 3072 + 2432 + ch) : (u32x4){0u, 0u, 0u, 0u};
    }
    float cw[5][8], cb[8];
#pragma unroll
    for (int w = 0; w < 5; ++w) {
      const float4 c0 = *(const float4*)(p.in[25] + (size_t)(l * 5 + w) * 512 + ch), c1 = *(const float4*)(p.in[25] + (size_t)(l * 5 + w) * 512 + ch + 4);
      cw[w][0] = c0.x; cw[w][1] = c0.y; cw[w][2] = c0.z; cw[w][3] = c0.w; cw[w][4] = c1.x; cw[w][5] = c1.y; cw[w][6] = c1.z; cw[w][7] = c1.w;
    }
    {
      const float4 c0 = *(const float4*)(p.in[26] + l * 512 + ch), c1 = *(const float4*)(p.in[26] + l * 512 + ch + 4);
      cb[0] = c0.x; cb[1] = c0.y; cb[2] = c0.z; cb[3] = c0.w; cb[4] = c1.x; cb[5] = c1.y; cb[6] = c1.z; cb[7] = c1.w;
    }
#pragma unroll
    for (int jj = 0; jj < 8; ++jj) {
      const int j = jb + jj;
      float a[8];
#pragma unroll
      for (int e = 0; e < 8; ++e) a[e] = cb[e];
#pragma unroll
      for (int w = 0; w < 5; ++w)
#pragma unroll
        for (int e = 0; e < 4; ++e) { a[2 * e] += lo2f(xr[jj + w][e]) * cw[w][2 * e]; a[2 * e + 1] += hi2f(xr[jj + w][e]) * cw[w][2 * e + 1]; }
#pragma unroll
      for (int e = 0; e < 8; ++e) a[e] = silu(a[e]);
      u32x4 o; o[0] = pack2(a[0], a[1]); o[1] = pack2(a[2], a[3]); o[2] = pack2(a[4], a[5]); o[3] = pack2(a[6], a[7]);
      *(u32x4*)(XBC + (size_t)(t0 + j) * 512 + ch) = o;
      if (co < 16) {
#pragma unroll
        for (int e = 0; e < 8; ++e) XsT[(co * 8 + e) * 72 + j] = f2bf(a[e]);
      } else if (co < 24) {
        const int s2 = (co - 16) * 8;
#pragma unroll
        for (int cb4 = 0; cb4 < 4; ++cb4) {
          const float wj = WJ[cb4 * 64 + j];
#pragma unroll
          for (int e = 0; e < 8; ++e) BwT[(cb4 * 64 + s2 + e) * 72 + j] = f2bf(a[e] * wj);
        }
      }
    }
  }
  __syncthreads();
  {
    const int lane = tid & 63, w = tid >> 6, r = lane & 15, g = lane >> 4;
    const int dir = w >> 1, hd = w & 1, head = grp * 2 + hd;
    float* ST = (float*)(p.ws + WS_SST) + (size_t)((tt * 2 + dir) * 4 + head) * 4096;
    for (int pt = 0; pt < 4; ++pt) {
      bf16x8 b0 = ldfrag(XsT + (hd * 64 + pt * 16 + r) * 72 + g * 8), b1 = ldfrag(XsT + (hd * 64 + pt * 16 + r) * 72 + 32 + g * 8);
#pragma unroll
      for (int st = 0; st < 4; ++st) {
        f32x4 acc = (f32x4){0.f, 0.f, 0.f, 0.f};
        acc = mfma(ldfrag(BwT + (w * 64 + st * 16 + r) * 72 + g * 8), b0, acc);
        acc = mfma(ldfrag(BwT + (w * 64 + st * 16 + r) * 72 + 32 + g * 8), b1, acc);
        *(float4*)(ST + (pt * 16 + r) * 64 + st * 16 + g * 4) = make_float4(acc[0], acc[1], acc[2], acc[3]);
      }
    }
    if (tid < 4) ((float*)(p.ws + WS_SDEC))[(tt * 2 + (tid >> 1)) * 4 + grp * 2 + (tid & 1)] = __expf(TOT[tid]);
  }
  __syncthreads();
}

template <int KS>
DI void attn_block(const u16* __restrict__ Q, int qstride, const u16* __restrict__ K, int kstride, const u16* __restrict__ VT, int nk,
                   const u16* __restrict__ gate, u16* ocat, int tokb, char* smem) {
  constexpr int KLD = KS == 2 ? 64 : 128;
  constexpr int BUF = 64 * KLD + 64 * 64;
  constexpr int KCH = KS * 4;
  u16* sm = (u16*)smem;
  const int tid = otid(), lane = tid & 63, w = tid >> 6, r = lane & 15, g = lane >> 4;
  const int tok0 = tokb + w * 32;
  bf16x8 qf[2][KS];
#pragma unroll
  for (int q = 0; q < 2; ++q)
#pragma unroll
    for (int s = 0; s < KS; ++s) qf[q][s] = ldfrag(Q + (size_t)(tok0 + q * 16 + r) * qstride + s * 32 + g * 8);
  f32x4 o[2][4];
#pragma unroll
  for (int q = 0; q < 2; ++q)
#pragma unroll
    for (int e = 0; e < 4; ++e) o[q][e] = (f32x4){0.f, 0.f, 0.f, 0.f};
  float m[2] = {-1e30f, -1e30f}, lsum[2] = {0.f, 0.f};
  u32x4 rk0[KS], rv0[2], rk1[KS], rv1[2];
  int koff[KS], voff[2];
#pragma unroll
  for (int i = 0; i < KS; ++i) {
    const int id = tid + 256 * i, row = id / KCH, ch = id % KCH;
    const int f = KS == 2 ? (((row >> 1) & 1) | (((row >> 3) & 3) << 1)) : ((row & 3) | (((row >> 3) & 3) << 2));
    koff[i] = row * KLD + ((ch ^ f) * 8);
  }
#pragma unroll
  for (int i = 0; i < 2; ++i) { const int id = tid + 256 * i, row = id >> 3, ch = id & 7; voff[i] = 64 * KLD + row * 64 + ((ch ^ ((row >> 1) & 7)) * 8); }
  const int nit = nk >> 6;
  const int qtile = (tokb >> 7) & 15;
  const int start = (qtile * nit) >> 4;
  auto gload = [&](u32x4* rk, u32x4* rv, int it) {
    int tix = it + start; if (tix >= nit) tix -= nit;
    const int k0 = tix * 64;
#pragma unroll
    for (int i = 0; i < KS; ++i) { const int id = tid + 256 * i; rk[i] = *(const u32x4*)(K + (size_t)(k0 + id / KCH) * kstride + (id % KCH) * 8); }
#pragma unroll
    for (int i = 0; i < 2; ++i) { const int id = tid + 256 * i; rv[i] = *(const u32x4*)(VT + (size_t)(id >> 3) * nk + k0 + (id & 7) * 8); }
  };
  auto lstore = [&](const u32x4* rk, const u32x4* rv, int bufi) {
    u16* nb = sm + bufi * BUF;
#pragma unroll
    for (int i = 0; i < KS; ++i) *(u32x4*)(nb + koff[i]) = rk[i];
#pragma unroll
    for (int i = 0; i < 2; ++i) *(u32x4*)(nb + voff[i]) = rv[i];
  };
  const int krow0 = (r >> 2) * 8 + (r & 3);
  const int fk = KS == 2 ? (((krow0 >> 1) & 1) | (((krow0 >> 3) & 3) << 1)) : ((krow0 & 3) | (((krow0 >> 3) & 3) << 2));
  const int fv = (r >> 1) & 7;
  auto compute = [&](int bufi) {
    const u16* kb = sm + bufi * BUF; const u16* vb = kb + 64 * KLD;
    f32x4 sc[2][2][2];
#pragma unroll
    for (int sb = 0; sb < 2; ++sb) {
      const int krow = sb * 32 + krow0;
#pragma unroll
      for (int q = 0; q < 2; ++q) { sc[q][sb][0] = (f32x4){0.f, 0.f, 0.f, 0.f}; sc[q][sb][1] = sc[q][sb][0]; }
#pragma unroll
      for (int s = 0; s < KS; ++s) {
        const int co = ((s * 4 + g) ^ fk) * 8;
        const bf16x8 k0f = ldfrag(kb + krow * KLD + co), k1f = ldfrag(kb + (krow + 4) * KLD + co);
#pragma unroll
        for (int q = 0; q < 2; ++q) { sc[q][sb][0] = mfma(k0f, qf[q][s], sc[q][sb][0]); sc[q][sb][1] = mfma(k1f, qf[q][s], sc[q][sb][1]); }
      }
    }
    bf16x8 pf[2][2];
#pragma unroll
    for (int q = 0; q < 2; ++q) {
      float mx = fmaxf(fmaxf(fmaxf(sc[q][0][0][0], sc[q][0][0][1]), fmaxf(sc[q][0][0][2], sc[q][0][0][3])), fmaxf(fmaxf(sc[q][0][1][0], sc[q][0][1][1]), fmaxf(sc[q][0][1][2], sc[q][0][1][3])));
      const float mx1 = fmaxf(fmaxf(fmaxf(sc[q][1][0][0], sc[q][1][0][1]), fmaxf(sc[q][1][0][2], sc[q][1][0][3])), fmaxf(fmaxf(sc[q][1][1][0], sc[q][1][1][1]), fmaxf(sc[q][1][1][2], sc[q][1][1][3])));
      mx = fmaxf(mx, mx1);
      mx = xmax16(mx); mx = xmax32(mx);
      if (__any(mx > m[q])) {
        const float mnew = fmaxf(m[q], mx);
        const float alpha = __builtin_amdgcn_exp2f(m[q] - mnew);
        m[q] = mnew;
        lsum[q] *= alpha;
#pragma unroll
        for (int e = 0; e < 4; ++e) o[q][e] = o[q][e] * alpha;
      }
#pragma unroll
      for (int sb = 0; sb < 2; ++sb) {
        float pp[8];
#pragma unroll
        for (int i = 0; i < 4; ++i) { pp[i] = __builtin_amdgcn_exp2f(sc[q][sb][0][i] - m[q]); pp[4 + i] = __builtin_amdgcn_exp2f(sc[q][sb][1][i] - m[q]); }
        lsum[q] += ((pp[0] + pp[1]) + (pp[2] + pp[3])) + ((pp[4] + pp[5]) + (pp[6] + pp[7]));
        u32x4 pk; pk[0] = pack2(pp[0], pp[1]); pk[1] = pack2(pp[2], pp[3]); pk[2] = pack2(pp[4], pp[5]); pk[3] = pack2(pp[6], pp[7]);
        pf[q][sb] = __builtin_bit_cast(bf16x8, pk);
      }
    }
#pragma unroll
    for (int sb = 0; sb < 2; ++sb) {
      const int vo = ((sb * 4 + g) ^ fv) * 8;
#pragma unroll
      for (int e = 0; e < 4; ++e) {
        const bf16x8 vf = ldfrag(vb + (e * 16 + r) * 64 + vo);
        o[0][e] = mfma(vf, pf[0][sb], o[0][e]);
        o[1][e] = mfma(vf, pf[1][sb], o[1][e]);
      }
    }
  };
  gload(rk0, rv0, 0);
  gload(rk1, rv1, 1);
  lstore(rk0, rv0, 0);
  __syncthreads();
  for (int it = 0; it < nit; it += 2) {
    if (it + 2 < nit) gload(rk0, rv0, it + 2);
    compute(0);
    lstore(rk1, rv1, 1);
    __syncthreads();
    if (it + 3 < nit) gload(rk1, rv1, it + 3);
    compute(1);
    if (it + 2 < nit) lstore(rk0, rv0, 0);
    __syncthreads();
  }
#pragma unroll
  for (int q = 0; q < 2; ++q) {
    float lt = lsum[q];
    lt = xsum16(lt); lt = xsum32(lt);
    const float inv = 1.f / lt;
    const int tok = tok0 + q * 16 + r;
#pragma unroll
    for (int e = 0; e < 4; ++e) {
      const int dv = e * 16 + g * 4;
      float gt[4]; ld4bf(gate + (size_t)tok * 3072 + dv, gt);
      st4bf(ocat + (size_t)tok * 1024 + dv, o[q][e][0] * inv * silu(gt[0]), o[q][e][1] * inv * silu(gt[1]), o[q][e][2] * inv * silu(gt[2]), o[q][e][3] * inv * silu(gt[3]));
    }
  }
}

DI void d_attn(const P& p, int kind, int seqtok0, int kvoff, int nk, int h, int qt, char* smem) {
  const u16* U = (const u16*)(p.ws + WS_U); u16* Ocat = (u16*)(p.ws + WS_H);
  const int tokb = seqtok0 + qt * 128;
  if (kind == 0) {
    const u16* Qg = (const u16*)(p.ws + WS_QG); const u16* Kg = (const u16*)(p.ws + WS_KG); const u16* VgT = (const u16*)(p.ws + WS_VGT);
    attn_block<2>(Qg + h * 64, 256, Kg + (size_t)kvoff * 128 + (h >> 1) * 64, 128, VgT + (size_t)kvoff * 128 + (size_t)(h >> 1) * 64 * nk, nk, U + 512 + h * 64, Ocat + h * 64, tokb, smem);
  } else {
    const u16* Qm = (const u16*)(p.ws + WS_QM); const u16* Km = (const u16*)(p.ws + WS_KM); const u16* VmT = (const u16*)(p.ws + WS_VMT);
    attn_block<3>(Qm + h * 96, 384, Km + (size_t)kvoff * 384 + h * 96, 384, VmT + (size_t)kvoff * 256 + (size_t)h * 64 * nk, nk, U + 1920 + h * 64, Ocat + 512 + h * 64, tokb, smem);
  }
}

DI void d_gla(const P& p, int l, int tt, int h, char* smem) {
  const TI ti = tile_info(tt);
  const int t0 = ti.t0;
  float* CB = (float*)smem; float* TT = CB + 4096;
  u16* ATT = (u16*)smem;
  u16* Qd = (u16*)(TT + 64);
  u16* Kin = Qd + 2 * 64 * 40;
  u16* VT = Kin + 2 * 64 * 40;
  u16* ST = VT + 64 * 72;
  const u16* U = (const u16*)(p.ws + WS_U);
  const int tid = otid();
  {
    const float* src = (const float*)(p.ws + WS_CBG) + (size_t)(tt * 4 + h) * 4160;
#pragma unroll
    for (int i = 0; i < 4; ++i) *(float4*)(CB + (tid + 256 * i) * 4) = *(const float4*)(src + (tid + 256 * i) * 4);
    if (tid < 16) *(float4*)(TT + tid * 4) = *(const float4*)(src + 4096 + tid * 4);
  }
  __syncthreads();
  {
    const int tok = tid >> 2, sub = tid & 3;
    float q[8], k[8];
    ld8bf(U + (size_t)(t0 + tok) * 3072 + 768 + h * 32 + sub * 8, q);
    ld8bf(U + (size_t)(t0 + tok) * 3072 + 896 + h * 32 + sub * 8, k);
#pragma unroll
    for (int dir = 0; dir < 2; ++dir) {
      float qd[8], ki[8];
#pragma unroll
      for (int e = 0; e < 8; ++e) { const float cb = CB[(dir * 64 + tok) * 32 + sub * 8 + e]; qd[e] = q[e] * 0.17677669529f * __expf(cb); ki[e] = k[e] * __expf(-cb); }
      st4bf(Qd + (dir * 64 + tok) * 40 + sub * 8, qd[0], qd[1], qd[2], qd[3]); st4bf(Qd + (dir * 64 + tok) * 40 + sub * 8 + 4, qd[4], qd[5], qd[6], qd[7]);
      st4bf(Kin + (dir * 64 + tok) * 40 + sub * 8, ki[0], ki[1], ki[2], ki[3]); st4bf(Kin + (dir * 64 + tok) * 40 + sub * 8 + 4, ki[4], ki[5], ki[6], ki[7]);
    }
    const u16* vs = U + (size_t)(t0 + tok) * 3072 + 1024 + h * 64 + sub * 16;
    u32x4 v0 = *(const u32x4*)vs, v1 = *(const u32x4*)(vs + 8);
#pragma unroll
    for (int e = 0; e < 4; ++e) {
      VT[(sub * 16 + e * 2) * 72 + tok] = (u16)(v0[e] & 0xffffu); VT[(sub * 16 + e * 2 + 1) * 72 + tok] = (u16)(v0[e] >> 16);
      VT[(sub * 16 + 8 + e * 2) * 72 + tok] = (u16)(v1[e] & 0xffffu); VT[(sub * 16 + 8 + e * 2 + 1) * 72 + tok] = (u16)(v1[e] >> 16);
    }
  }
  {
    const int d = tid >> 3, e0 = (tid & 7) * 8;
    const float* GUPD = (const float*)(p.ws + WS_GUPD); const float* GDEC = (const float*)(p.ws + WS_GDEC);
#pragma unroll
    for (int dir = 0; dir < 2; ++dir) {
      float S[8];
      if (!ti.isctx) {
        const float* up = GUPD + (size_t)((tt * 2 + dir) * 4 + h) * 2048 + tid * 8;
        const float4 a = *(const float4*)up, b4 = *(const float4*)(up + 4);
        S[0] = a.x; S[1] = a.y; S[2] = a.z; S[3] = a.w; S[4] = b4.x; S[5] = b4.y; S[6] = b4.z; S[7] = b4.w;
      } else {
        const int npred = dir == 0 ? ti.c : 3 - ti.c;
        float4 ua[4], ub[4]; float dc[4];
#pragma unroll
        for (int q = 0; q < 4; ++q) {
          if (q <= npred) {
            const int cc = dir == 0 ? q : 3 - q;
            const int chunk = tt - ti.c + cc;
            dc[q] = GDEC[((chunk * 2 + dir) * 4 + h) * 32 + d];
            const float* up = GUPD + (size_t)((chunk * 2 + dir) * 4 + h) * 2048 + tid * 8;
            ua[q] = *(const float4*)up; ub[q] = *(const float4*)(up + 4);
          }
        }
#pragma unroll
        for (int e = 0; e < 8; ++e) S[e] = 0.f;
#pragma unroll
        for (int q = 0; q < 3; ++q) {
          if (q < npred) {
            S[0] = dc[q] * S[0] + ua[q].x; S[1] = dc[q] * S[1] + ua[q].y; S[2] = dc[q] * S[2] + ua[q].z; S[3] = dc[q] * S[3] + ua[q].w;
            S[4] = dc[q] * S[4] + ub[q].x; S[5] = dc[q] * S[5] + ub[q].y; S[6] = dc[q] * S[6] + ub[q].z; S[7] = dc[q] * S[7] + ub[q].w;
          }
        }
        if (npred == 3) {
          float* o = p.out + OUT_SG + (size_t)(((ti.b * 2 + l) * 2 + dir) * 4 + h) * 2048 + tid * 8;
          *(float4*)o = make_float4(dc[3] * S[0] + ua[3].x, dc[3] * S[1] + ua[3].y, dc[3] * S[2] + ua[3].z, dc[3] * S[3] + ua[3].w);
          *(float4*)(o + 4) = make_float4(dc[3] * S[4] + ub[3].x, dc[3] * S[5] + ub[3].y, dc[3] * S[6] + ub[3].z, dc[3] * S[7] + ub[3].w);
        }
      }
#pragma unroll
      for (int e = 0; e < 8; ++e) ST[(dir * 64 + e0 + e) * 40 + d] = f2bf(S[e]);
    }
  }
  __syncthreads();
  const int lane = tid & 63, w = tid >> 6, r = lane & 15, g = lane >> 4;
  f32x4 o[4];
#pragma unroll
  for (int e = 0; e < 4; ++e) o[e] = (f32x4){0.f, 0.f, 0.f, 0.f};
  for (int dir = 0; dir < 2; ++dir) {
    const bf16x8 bq = ldfrag(Qd + (dir * 64 + w * 16 + r) * 40 + g * 8);
    const int itok = w * 16 + r;
#pragma unroll
    for (int jt = 0; jt < 4; ++jt) {
      f32x4 s = mfma(ldfrag(Kin + (dir * 64 + jt * 16 + r) * 40 + g * 8), bq, (f32x4){0.f, 0.f, 0.f, 0.f});
      float v[4];
#pragma unroll
      for (int i = 0; i < 4; ++i) { const int j = jt * 16 + g * 4 + i; const bool keep = dir == 0 ? (j <= itok) : (j >= itok); v[i] = keep ? s[i] : 0.f; }
      st4bf(ATT + itok * 72 + jt * 16 + g * 4, v[0], v[1], v[2], v[3]);
    }
    __syncthreads();
#pragma unroll
    for (int s = 0; s < 2; ++s) {
      const bf16x8 bt = ldfrag(ATT + (w * 16 + r) * 72 + s * 32 + g * 8);
#pragma unroll
      for (int et = 0; et < 4; ++et) o[et] = mfma(ldfrag(VT + (et * 16 + r) * 72 + s * 32 + g * 8), bt, o[et]);
    }
#pragma unroll
    for (int et = 0; et < 4; ++et) o[et] = mfma(ldfrag(ST + (dir * 64 + et * 16 + r) * 40 + g * 8), bq, o[et]);
    __syncthreads();
  }
  float ss = 0;
#pragma unroll
  for (int et = 0; et < 4; ++et) ss += o[et][0] * o[et][0] + o[et][1] * o[et][1] + o[et][2] * o[et][2] + o[et][3] * o[et][3];
  ss = xsum16(ss); ss = xsum32(ss);
  const float rr = rsqrtf(ss * (1.f / 64.f) + EPS);
  const int t = t0 + w * 16 + r;
  u16* Ocat = (u16*)(p.ws + WS_H);
#pragma unroll
  for (int et = 0; et < 4; ++et) {
    const int e = et * 16 + g * 4;
    float gt[4]; ld4bf(U + (size_t)t * 3072 + 1312 + h * 64 + e, gt);
    const float4 gn = *(const float4*)(p.in[20] + l * 64 + e);
    st4bf(Ocat + (size_t)t * 1024 + 256 + h * 64 + e, o[et][0] * rr * gn.x * silu(gt[0]), o[et][1] * rr * gn.y * silu(gt[1]), o[et][2] * rr * gn.z * silu(gt[2]), o[et][3] * rr * gn.w * silu(gt[3]));
  }
  __syncthreads();
}

DI void d_ssd(const P& p, int l, int tt, int grp, char* smem) {
  const TI ti = tile_info(tt);
  const int t0 = ti.t0;
  u16* XsT = (u16*)smem;
  u16* Bm = XsT + 128 * 72;
  u16* Cm = Bm + 64 * 72;
  u16* M = Cm + 64 * 72;
  u16* Hst = M + 64 * 72;
  float* DT = (float*)(Hst + 64 * 72);
  float* CUM = DT + 512; float* TOT = CUM + 512;
  const u16* U = (const u16*)(p.ws + WS_U);
  const float* SIDE = (const float*)(p.ws + WS_SIDE);
  const u16* XBC = (const u16*)(p.ws + WS_XBC);
  const float* SST = (const float*)(p.ws + WS_SST);
  const int tid = otid(), lane = tid & 63, w = tid >> 6, r = lane & 15, g = lane >> 4;
  {
    const int tok = tid & 63, head = tid >> 6;
#pragma unroll
    for (int dir = 0; dir < 2; ++dir) {
      const float raw = SIDE[(size_t)(t0 + tok) * 40 + 32 + dir * 4 + head] + p.in[27][(l * 2 + dir) * 4 + head];
      const float dt = softplus(raw);
      DT[(dir * 4 + head) * 64 + tok] = dt; CUM[(dir * 4 + head) * 64 + tok] = -__expf(p.in[28][(l * 2 + dir) * 4 + head]) * dt;
    }
  }
  __syncthreads();
  {
#pragma unroll
    for (int dir = 0; dir < 2; ++dir) {
      const int cb8 = dir * 4 + w;
      const int j = dir ? 63 - lane : lane;
      float v = CUM[cb8 * 64 + j];
      v = wave_incl_scan(v, lane);
      CUM[cb8 * 64 + j] = v;
      if (lane == 63) TOT[cb8] = v;
    }
  }
  float ss = 0;
  const int itok = w * 16 + r;
  const int t = t0 + itok;
  {
    f32x4 y[2][4];
#pragma unroll
    for (int a = 0; a < 2; ++a)
#pragma unroll
      for (int b = 0; b < 4; ++b) y[a][b] = (f32x4){0.f, 0.f, 0.f, 0.f};
    __syncthreads();
    {
      const int tok = tid >> 2, sub = tid & 3;
      const u16* xs = XBC + (size_t)(t0 + tok) * 512 + grp * 128 + sub * 32;
#pragma unroll
      for (int q = 0; q < 4; ++q) {
        u32x4 v = *(const u32x4*)(xs + q * 8);
#pragma unroll
        for (int e = 0; e < 4; ++e) { XsT[(sub * 32 + q * 8 + e * 2) * 72 + tok] = (u16)(v[e] & 0xffffu); XsT[(sub * 32 + q * 8 + e * 2 + 1) * 72 + tok] = (u16)(v[e] >> 16); }
      }
      const u16* bs = XBC + (size_t)(t0 + tok) * 512 + 256 + grp * 64 + sub * 16;
      *(u32x4*)(Bm + tok * 72 + sub * 16) = *(const u32x4*)bs; *(u32x4*)(Bm + tok * 72 + sub * 16 + 8) = *(const u32x4*)(bs + 8);
      const u16* cs = XBC + (size_t)(t0 + tok) * 512 + 384 + grp * 64 + sub * 16;
      *(u32x4*)(Cm + tok * 72 + sub * 16) = *(const u32x4*)cs; *(u32x4*)(Cm + tok * 72 + sub * 16 + 8) = *(const u32x4*)(cs + 8);
    }
    __syncthreads();
    f32x4 sc[4];
    const bf16x8 c0 = ldfrag(Cm + (w * 16 + r) * 72 + g * 8), c1 = ldfrag(Cm + (w * 16 + r) * 72 + 32 + g * 8);
#pragma unroll
    for (int jt = 0; jt < 4; ++jt) {
      sc[jt] = mfma(ldfrag(Bm + (jt * 16 + r) * 72 + g * 8), c0, (f32x4){0.f, 0.f, 0.f, 0.f});
      sc[jt] = mfma(ldfrag(Bm + (jt * 16 + r) * 72 + 32 + g * 8), c1, sc[jt]);
    }
#pragma unroll
    for (int hd = 0; hd < 2; ++hd) {
      const int head = grp * 2 + hd;
      for (int dir = 0; dir < 2; ++dir) {
        const int cb8 = dir * 4 + head;
        const float ci = CUM[cb8 * 64 + itok];
#pragma unroll
        for (int jt = 0; jt < 4; ++jt) {
          float v[4];
#pragma unroll
          for (int i = 0; i < 4; ++i) {
            const int j = jt * 16 + g * 4 + i; const bool keep = dir == 0 ? (j <= itok) : (j >= itok);
            v[i] = keep ? sc[jt][i] * __expf(ci - CUM[cb8 * 64 + j]) * DT[cb8 * 64 + j] : 0.f;
          }
          st4bf(M + itok * 72 + jt * 16 + g * 4, v[0], v[1], v[2], v[3]);
        }
        {
          const int pp = tid >> 2, s0 = (tid & 3) * 16;
          const float* SDEC = (const float*)(p.ws + WS_SDEC);
          for (int hf = 0; hf < 2; ++hf) {
            float hs[8];
            if (!ti.isctx) {
              const float* st = SST + (size_t)((tt * 2 + dir) * 4 + head) * 4096 + tid * 16 + hf * 8;
              const float4 a = ((const float4*)st)[0], b4 = ((const float4*)st)[1];
              hs[0] = a.x; hs[1] = a.y; hs[2] = a.z; hs[3] = a.w; hs[4] = b4.x; hs[5] = b4.y; hs[6] = b4.z; hs[7] = b4.w;
            } else {
              const int npred = dir == 0 ? ti.c : 3 - ti.c;
              float4 ua[4], ub[4]; float dc[4];
#pragma unroll
              for (int q = 0; q < 4; ++q) {
                if (q <= npred) {
                  const int cc = dir == 0 ? q : 3 - q;
                  const int chunk = tt - ti.c + cc;
                  dc[q] = SDEC[(chunk * 2 + dir) * 4 + head];
                  const float* st = SST + (size_t)((chunk * 2 + dir) * 4 + head) * 4096 + tid * 16 + hf * 8;
                  ua[q] = ((const float4*)st)[0]; ub[q] = ((const float4*)st)[1];
                }
              }
#pragma unroll
              for (int e = 0; e < 8; ++e) hs[e] = 0.f;
#pragma unroll
              for (int q = 0; q < 3; ++q) {
                if (q < npred) {
                  hs[0] = dc[q] * hs[0] + ua[q].x; hs[1] = dc[q] * hs[1] + ua[q].y; hs[2] = dc[q] * hs[2] + ua[q].z; hs[3] = dc[q] * hs[3] + ua[q].w;
                  hs[4] = dc[q] * hs[4] + ub[q].x; hs[5] = dc[q] * hs[5] + ub[q].y; hs[6] = dc[q] * hs[6] + ub[q].z; hs[7] = dc[q] * hs[7] + ub[q].w;
                }
              }
              if (npred == 3) {
                float* o = p.out + OUT_SS + (size_t)(((ti.b * 2 + l) * 2 + dir) * 4 + head) * 4096 + tid * 16 + hf * 8;
                ((float4*)o)[0] = make_float4(dc[3] * hs[0] + ua[3].x, dc[3] * hs[1] + ua[3].y, dc[3] * hs[2] + ua[3].z, dc[3] * hs[3] + ua[3].w);
                ((float4*)o)[1] = make_float4(dc[3] * hs[4] + ub[3].x, dc[3] * hs[5] + ub[3].y, dc[3] * hs[6] + ub[3].z, dc[3] * hs[7] + ub[3].w);
              }
            }
            st4bf(Hst + pp * 72 + s0 + hf * 8, hs[0], hs[1], hs[2], hs[3]); st4bf(Hst + pp * 72 + s0 + hf * 8 + 4, hs[4], hs[5], hs[6], hs[7]);
          }
        }
        __syncthreads();
        const float ei = __expf(ci);
        const bf16x8 m0 = ldfrag(M + (w * 16 + r) * 72 + g * 8), m1 = ldfrag(M + (w * 16 + r) * 72 + 32 + g * 8);
#pragma unroll
        for (int pt = 0; pt < 4; ++pt) {
          y[hd][pt] = mfma(ldfrag(XsT + (hd * 64 + pt * 16 + r) * 72 + g * 8), m0, y[hd][pt]);
          y[hd][pt] = mfma(ldfrag(XsT + (hd * 64 + pt * 16 + r) * 72 + 32 + g * 8), m1, y[hd][pt]);
          f32x4 tmp = mfma(ldfrag(Hst + (pt * 16 + r) * 72 + g * 8), c0, (f32x4){0.f, 0.f, 0.f, 0.f});
          tmp = mfma(ldfrag(Hst + (pt * 16 + r) * 72 + 32 + g * 8), c1, tmp);
          y[hd][pt] = y[hd][pt] + tmp * ei;
        }
        __syncthreads();
      }
      const float dsk = p.in[29][l * 4 + head];
#pragma unroll
      for (int pt = 0; pt < 4; ++pt) {
        float z[4]; ld4bf(U + (size_t)t * 3072 + 2176 + head * 64 + pt * 16 + g * 4, z);
        float v[4];
#pragma unroll
        for (int i = 0; i < 4; ++i) {
          v[i] = (y[hd][pt][i] + dsk * bf2f(XsT[(hd * 64 + pt * 16 + g * 4 + i) * 72 + itok])) * silu(z[i]);
          ss += v[i] * v[i];
        }
        const int c = head * 64 + pt * 16 + g * 4;
        const float4 gn = *(const float4*)(p.in[30] + l * 256 + c);
        st4bf((u16*)(p.ws + WS_H) + (size_t)t * 1024 + 768 + c, v[0] * gn.x, v[1] * gn.y, v[2] * gn.z, v[3] * gn.w);
      }
    }
  }
  ss = xsum16(ss); ss = xsum32(ss);
  if (g == 0) ((float*)(p.ws + WS_SSQ))[t * 2 + grp] = ss;
  __syncthreads();
}


DI void scan_latent_item(const P& p, int l, int L) {
  float* GUPD = (float*)(p.ws + WS_GUPD); const float* GDEC = (const float*)(p.ws + WS_GDEC);
  float* SST = (float*)(p.ws + WS_SST); const float* SDEC = (const float*)(p.ws + WS_SDEC);
  const int e = L % 1536; const int rest = L / 1536; const int head = rest & 3, dir = (rest >> 2) & 1, b = rest >> 3;
  const int tt0 = 128 + b * 32;
  const bool gla = e < 512;
  const int e4 = gla ? e * 4 : (e - 512) * 4;
  const int esz = gla ? 2048 : 4096;
  float* base = gla ? GUPD : SST;
  float4 S = *(const float4*)((gla ? p.in[7] : p.in[8]) + (size_t)(((b * 2 + l) * 2 + dir) * 4 + head) * esz + e4);
  for (int q0 = 0; q0 < 32; q0 += 16) {
    float4 u[16]; float dec[16];
    const int c0 = dir == 0 ? q0 : 31 - q0, cs = dir == 0 ? 1 : -1;
    float* upb = base + (size_t)(((tt0 + c0) * 2 + dir) * 4 + head) * esz + e4;
    const ptrdiff_t ust = (ptrdiff_t)cs * 8 * esz;
    const float* dcb = gla ? GDEC + (((tt0 + c0) * 2 + dir) * 4 + head) * 32 + (e4 >> 6) : SDEC + ((tt0 + c0) * 2 + dir) * 4 + head;
    const int dst = cs * (gla ? 256 : 8);
#pragma unroll
    for (int k = 0; k < 16; ++k) { u[k] = *(const float4*)(upb + k * ust); dec[k] = dcb[k * dst]; }
#pragma unroll
    for (int k = 0; k < 16; ++k) {
      *(float4*)(upb + k * ust) = S;
      S.x = dec[k] * S.x + u[k].x; S.y = dec[k] * S.y + u[k].y; S.z = dec[k] * S.z + u[k].z; S.w = dec[k] * S.w + u[k].w;
    }
  }
}

DI void phaseB(const P& p, int l, char* smem) {
  const int xcd = blockIdx.x & 7, slot = blockIdx.x >> 3, nslot = gridDim.x >> 3;
  for (int i = slot; i < 288; i += nslot) {
    const int ntb = i / 96, rem = i % 96;
    gemm_tile<0>((const u16*)(p.ws + WS_H), (const u16*)(p.ws + WS_WINT) + (size_t)l * 3072 * 1024, xcd * 12 + (rem >> 3), ntb * 8 + (rem & 7), p.ws + WS_U, (float*)(p.ws + WS_SIDE), smem);
  }
}
DI void phaseE(const P& p, int l, char* smem) {
  const int xcd = blockIdx.x & 7, slot = blockIdx.x >> 3, nslot = gridDim.x >> 3;
  for (int i = slot; i < 128; i += nslot)
    gemm_tile<1>((const u16*)(p.ws + WS_H), (const u16*)(p.ws + WS_WOUTT) + (size_t)l * 1024 * 1024, xcd * 16 + (i >> 3), i & 7, p.ws + WS_U, (float*)(p.ws + WS_SSQ), smem);
}
DI void phaseC(const P& p, int l, char* smem) {
  for (int job = blockIdx.x; job < 1744; job += gridDim.x) {
    if (job < 384) c_ssd(p, l, job >> 1, job & 1, smem);
    else if (job >= 400 && job < 416) c_cache(p, l, job - 400, smem);
    else if (job < 1360) { const int idx = job < 400 ? job - 384 : job - 400; if (idx < 768) c_gla(p, l, idx >> 2, idx & 3, smem); else c_gqa(p, l, idx - 768, smem); }
    else { const int idx = job - 1360; if (idx < 192) c_mla_q(p, l, idx, smem); else c_mla_kv(p, l, idx - 192, smem); }
  }
}
DI void d_light(const P& p, int l, int j, char* smem) {
  if (j < 384) d_ssd(p, l, j >> 1, j & 1, smem);
  else if (j < 1152) { const int q = j - 384; d_gla(p, l, q >> 2, q & 3, smem); }
  else {
    const int q = j - 1152; const int kind = q >> 8, rem = q & 255; const int seq = rem >> 3, h = (rem >> 1) & 3, qt = rem & 1;
    d_attn(p, kind, seq * 256, seq * 256, 256, h, qt, smem);
  }
}
#define XB_SDONE(i) (XCD_BAR_WORDS + 64 * (i))
#define BAR_TOTAL_WORDS (XCD_BAR_WORDS + 64 * 4)
DI void phaseD(const P& p, int l, char* smem, const XcdBarrier& xb) {
  const int bid = blockIdx.x, G = gridDim.x, tid0 = otid();
  unsigned* sdone = (unsigned*)(p.ws + WS_BAR) + XB_SDONE(l);
  bool scan_ready = false;
  if (G == 512) {
    if (bid >= 416) {
      scan_latent_item(p, l, (bid - 416) * 256 + tid0);
      asm volatile("s_waitcnt vmcnt(0)" ::: "memory");
      __syncthreads();
      if (tid0 == 0) {
        __builtin_amdgcn_fence(__ATOMIC_RELEASE, "agent");
        asm volatile("s_waitcnt vmcnt(0)" ::: "memory");
        (void)xb_add(sdone, 1u);
      }
    }
  } else {
    for (int L = bid * 256 + tid0; L < 24576; L += G * 256) scan_latent_item(p, l, L);
    xcd_barrier(xb);
    scan_ready = true;
  }
  for (int step = 0;; ++step) {
    int heavy = -1, light = -1;
    if (G == 512) {
      if (step > 4) break;
      if (bid < 256) { if (step == 0) heavy = bid; else if (step == 1) light = 1152 + bid; else if (step == 2) light = 896 + bid; }
      else {
        const int nb = bid - 256;
        if (nb < 128) { if (step < 4) light = step * 128 + nb; }
        else if (step < 3) light = 384 + step * 128 + nb;
        else light = 1408 + (nb - 128) * 2 + (step - 3);
      }
    } else {
      const int job = bid + step * G;
      if (job >= 256 + 1664) break;
      if (job < 256) heavy = job; else light = job - 256;
    }
    if (heavy >= 0) {
      const int combo = (heavy & 7) * 2 + (heavy >> 7), qt = (heavy >> 3) & 15;
      const int kind = combo >> 3, b = (combo >> 2) & 1, h = combo & 3;
      d_attn(p, kind, 8192 + b * 2048, 8192 + b * 2560, 2560, h, qt, smem);
    } else if (light >= 0) {
      const bool latent_tile = light < 384 ? (light >> 1) >= 128 : (light < 1152 ? ((light - 384) >> 2) >= 128 : false);
      if (latent_tile && !scan_ready) {
        if (tid0 == 0) {
          unsigned sp = 0;
          while (xb_ld(sdone) < 96u) { __builtin_amdgcn_s_sleep(1); if (++sp > (1u << 22)) break; }
          __builtin_amdgcn_fence(__ATOMIC_ACQUIRE, "agent");
          asm volatile("s_waitcnt vmcnt(0)" ::: "memory");
        }
        __syncthreads();
        scan_ready = true;
      }
      d_light(p, l, light, smem);
    }
  }
}

__global__ void __launch_bounds__(256, 2) mega(P p) {
  __shared__ __attribute__((aligned(16))) char smem[SMEM_BYTES];
  __shared__ uint4 xb_words;
  if (threadIdx.x == 0) xb_words = make_uint4(0u, 0u, 0u, 0u);
  __syncthreads();
  const XcdBarrier xb = xcd_barrier_post((unsigned*)(p.ws + WS_BAR), (volatile LAS unsigned*)&xb_words);
  if (p.out == nullptr) cg::this_grid().sync();
  phase0(p, smem);
  xcd_barrier(xb);
  for (int l = 0; l < 2; ++l) {
    phaseA(p, l); xcd_barrier(xb);
    phaseB(p, l, smem); xcd_barrier(xb);
    phaseC(p, l, smem); xcd_barrier(xb);
    phaseD(p, l, smem, xb); xcd_barrier(xb);
    phaseE(p, l, smem); xcd_barrier(xb);
  }
  phaseA(p, 2);
}

extern "C" void kernel_launch(void* const* d_in, const int* in_sizes, int n_in, void* d_out, int out_size, void* d_ws, size_t ws_size, hipStream_t stream) {
  static int grid_blocks = 0;
  if (!grid_blocks) {
    int dev = 0, cus = 0, per_cu = 0;
    hipGetDevice(&dev);
    hipDeviceGetAttribute(&cus, hipDeviceAttributeMultiprocessorCount, dev);
    hipOccupancyMaxActiveBlocksPerMultiprocessor(&per_cu, mega, 256, 0);
    if (per_cu > 2) per_cu = 2;
    if (per_cu < 1) per_cu = 1;
    grid_blocks = cus * per_cu;
  }
  P p{};
  for (int i = 0; i < 31; ++i) p.in[i] = (const float*)d_in[i];
  p.out = (float*)d_out;
  p.ws = (char*)d_ws;
  hipMemsetAsync((char*)d_ws + WS_BAR, 0, BAR_TOTAL_WORDS * sizeof(unsigned), stream);
  void* args[] = {&p};
  hipError_t e = hipLaunchCooperativeKernel((void*)mega, dim3(grid_blocks), dim3(256), args, 0, stream);
  if (e != hipSuccess) fprintf(stderr, "cooperative launch failed: %s (grid %d)\n", hipGetErrorString(e), grid_blocks);
}
#ifdef SPLIT_TEST
__global__ void __launch_bounds__(256, 2) k_p0(P p) { __shared__ __attribute__((aligned(16))) char smem[SMEM_BYTES]; phase0(p, smem); }
__global__ void __launch_bounds__(256, 2) k_a(P p, int l) { phaseA(p, l); }
__global__ void __launch_bounds__(256, 2) k_b(P p, int l) { __shared__ __attribute__((aligned(16))) char smem[SMEM_BYTES]; phaseB(p, l, smem); }
__global__ void __launch_bounds__(256, 2) k_e(P p, int l) { __shared__ __attribute__((aligned(16))) char smem[SMEM_BYTES]; phaseE(p, l, smem); }
__global__ void __launch_bounds__(256, 2) k_cmla(P p, int l) { __shared__ __attribute__((aligned(16))) char smem[SMEM_BYTES]; c_mla_q(p, l, blockIdx.x, smem); c_mla_kv(p, l, blockIdx.x, smem); }
__global__ void __launch_bounds__(256, 2) k_ccache(P p, int l) { __shared__ __attribute__((aligned(16))) char smem[SMEM_BYTES]; c_cache(p, l, blockIdx.x, smem); }
__global__ void __launch_bounds__(256, 2) k_cssd(P p, int l) { __shared__ __attribute__((aligned(16))) char smem[SMEM_BYTES]; c_ssd(p, l, blockIdx.x, blockIdx.y, smem); }
__global__ void __launch_bounds__(256, 2) k_cgqa(P p, int l) { __shared__ __attribute__((aligned(16))) char smem[SMEM_BYTES]; c_gqa(p, l, blockIdx.x, smem); }
__global__ void __launch_bounds__(256, 2) k_cgla(P p, int l) { __shared__ __attribute__((aligned(16))) char smem[SMEM_BYTES]; c_gla(p, l, blockIdx.x, blockIdx.y, smem); }
__global__ void __launch_bounds__(256, 2) k_dattn(P p, int l) { __shared__ __attribute__((aligned(16))) char smem[SMEM_BYTES]; d_attn(p, blockIdx.y, 0, 0, 256 + 256 * l, blockIdx.x & 3, blockIdx.x >> 2, smem); }
__global__ void __launch_bounds__(256, 2) k_dgla(P p, int l) { __shared__ __attribute__((aligned(16))) char smem[SMEM_BYTES]; d_gla(p, l, blockIdx.x, blockIdx.y, smem); }
__global__ void __launch_bounds__(256, 2) k_dssd(P p, int l) { __shared__ __attribute__((aligned(16))) char smem[SMEM_BYTES]; d_ssd(p, l, blockIdx.x, blockIdx.y, smem); }
#endif
```

```cpp
#include <hip/hip_runtime.h>
#include <hip/hip_cooperative_groups.h>
#include <cstdio>
namespace cg = cooperative_groups;

typedef unsigned short u16;
using bf16x8 = __attribute__((ext_vector_type(8))) short;
using f32x4 = __attribute__((ext_vector_type(4))) float;
using u32x4 = __attribute__((ext_vector_type(4))) unsigned;
#define DI __device__ __forceinline__

static constexpr size_t WS_MOD = 0;
static constexpr size_t WS_BAR = 512ull << 10;
static constexpr size_t WS_WINT = 1ull << 20;
static constexpr size_t WS_WOUTT = WS_WINT + 2ull * 3072 * 1024 * 2;
static constexpr size_t WS_WUQT = WS_WOUTT + 2ull * 1024 * 1024 * 2;
static constexpr size_t WS_WUKVT = WS_WUQT + 2ull * 384 * 192 * 2;
static constexpr size_t WS_H = WS_WUKVT + 2ull * 512 * 128 * 2;
static constexpr size_t WS_U = WS_H + 12288ull * 1024 * 2;
static constexpr size_t WS_SIDE = WS_U + 12288ull * 3072 * 2;
static constexpr size_t WS_QG = WS_SIDE + 12288ull * 40 * 4;
static constexpr size_t WS_KG = WS_QG + 12288ull * 256 * 2;
static constexpr size_t WS_VGT = WS_KG + 13312ull * 128 * 2;
static constexpr size_t WS_QM = WS_VGT + 13312ull * 128 * 2;
static constexpr size_t WS_KM = WS_QM + 12288ull * 384 * 2;
static constexpr size_t WS_VMT = WS_KM + 13312ull * 384 * 2;
static constexpr size_t WS_XBC = WS_VMT + 13312ull * 256 * 2;
static constexpr size_t WS_GUPD = WS_XBC + 12288ull * 512 * 2;
static constexpr size_t WS_GDEC = WS_GUPD + 192ull * 2 * 4 * 2048 * 4;
static constexpr size_t WS_SST = WS_GDEC + 192ull * 2 * 4 * 32 * 4;
static constexpr size_t WS_SDEC = WS_SST + 192ull * 2 * 4 * 4096 * 4;
static constexpr size_t WS_SSQ = WS_SDEC + 192ull * 8 * 4;
static constexpr size_t WS_CBG = WS_SSQ + 12288ull * 2 * 4;
static constexpr size_t WS_END = WS_CBG + 768ull * 4160 * 4;

static constexpr int OUT_GK = 12582912;
static constexpr int OUT_GV = OUT_GK + 2097152;
static constexpr int OUT_CKV = OUT_GV + 2097152;
static constexpr int OUT_KR = OUT_CKV + 2097152;
static constexpr int OUT_SG = OUT_KR + 524288;
static constexpr int OUT_SS = OUT_SG + 1048576;

static constexpr int SMEM_BYTES = 73728;
#define EPS 1e-6f
#define QSC_G (0.125f * 1.44269504089f)

#define XB_TMO      128
#define XB_XCNT(j)  (256  + 64 * (j))
#define XB_XSUB(j)  (1280 + 64 * (j))
#define XB_XGEN(j)  (2304 + 64 * (j))
#define XB_TOP      3328
#define XB_TOPGEN   3392
#define XCD_BAR_WORDS 3456
#define XB_SPIN_CAP (1u << 18)
#define LAS __attribute__((address_space(3)))

__device__ __forceinline__ unsigned xb_ld(unsigned* p)              { return __hip_atomic_load(p, __ATOMIC_RELAXED, __HIP_MEMORY_SCOPE_AGENT); }
__device__ __forceinline__ unsigned xb_add(unsigned* p, unsigned v) { return __hip_atomic_fetch_add(p, v, __ATOMIC_RELAXED, __HIP_MEMORY_SCOPE_AGENT); }
__device__ __forceinline__ unsigned xb_xcc_id() { return (unsigned)__builtin_amdgcn_s_getreg((3 << 11) | 20) & 0xFu; }
#define XB_SPIN(cond, bar) do { unsigned _sp = 0; while (cond) { __builtin_amdgcn_s_sleep(1); \
    if ((++_sp & 255u) == 0u) { if (xb_ld(&(bar)[XB_TMO])) break; if (_sp > XB_SPIN_CAP) { atomicAdd(&(bar)[XB_TMO], 1u); break; } } } } while (0)

struct XcdBarrier {
    unsigned* bar; unsigned x;
    volatile LAS unsigned* st;
};

__device__ __forceinline__ XcdBarrier xcd_barrier_post(unsigned* bar, volatile LAS unsigned* st) {
    XcdBarrier b; b.bar = bar; b.x = xb_xcc_id(); b.st = st;
    if (threadIdx.x == 0) (void)xb_add(&bar[XB_XCNT(b.x)], 1u);
    return b;
}
__device__ __forceinline__ void xcd_barrier_complete(unsigned* bar, unsigned x, unsigned& nloc, unsigned& nx) {
    const unsigned G = gridDim.x * gridDim.y * gridDim.z;
    unsigned sum, cnt, mine, sp = 0u;
    for (;;) {
        sum = 0u; cnt = 0u; mine = 0u;
#pragma unroll
        for (unsigned j = 0; j < 16; ++j) { const unsigned c = xb_ld(&bar[XB_XCNT(j)]); sum += c; cnt += (c > 0u) ? 1u : 0u; mine = (j == x) ? c : mine; }
        if (sum == G) break;
        __builtin_amdgcn_s_sleep(1);
        if ((++sp & 255u) == 0u) { if (xb_ld(&bar[XB_TMO])) break; if (sp > XB_SPIN_CAP) { atomicAdd(&bar[XB_TMO], 1u); break; } }
    }
    nloc = mine > 0u ? mine : 1u; nx = cnt > 0u ? cnt : 1u;
}

__device__ __forceinline__ void xcd_barrier(const XcdBarrier& b) {
    asm volatile("s_waitcnt vmcnt(0)" ::: "memory");
    __syncthreads();
    if (threadIdx.x == 0) {
        unsigned* bar = b.bar;
        __builtin_amdgcn_s_waitcnt(0);
        unsigned nloc = b.st[0], nx = b.st[1];
        if (nloc == 0u) { xcd_barrier_complete(bar, b.x, nloc, nx); b.st[0] = nloc; b.st[1] = nx; }
        const unsigned old = xb_add(&bar[XB_XSUB(b.x)], 1u);
        const unsigned gen = old / nloc;
        if (old + 1u == (gen + 1u) * nloc) {
            __builtin_amdgcn_fence(__ATOMIC_RELEASE, "agent");
            asm volatile("s_waitcnt vmcnt(0)" ::: "memory");
            const unsigned og = xb_add(&bar[XB_TOP], 1u);
            const unsigned tg = og / nx;
            if (og + 1u == (tg + 1u) * nx) xb_add(&bar[XB_TOPGEN], 1u);
            else XB_SPIN(xb_ld(&bar[XB_TOPGEN]) == tg, bar);
            __builtin_amdgcn_fence(__ATOMIC_ACQUIRE, "agent");
            xb_add(&bar[XB_XGEN(b.x)], 1u);
            asm volatile("s_waitcnt vmcnt(0)" ::: "memory");
        } else {
            XB_SPIN(xb_ld(&bar[XB_XGEN(b.x)]) == gen, bar);
            __builtin_amdgcn_fence(__ATOMIC_ACQUIRE, "agent");
            asm volatile("s_waitcnt vmcnt(0)" ::: "memory");
        }
    }
    __syncthreads();
}


struct P {
  const float* in[31];
  float* out;
  char* ws;
};

DI int otid() { int t = threadIdx.x; asm volatile("" : "+v"(t)); return t; }
typedef float f32x2_t __attribute__((ext_vector_type(2)));
typedef __bf16 bf16x2_t __attribute__((ext_vector_type(2)));
DI u16 f2bf(float x) { return __builtin_bit_cast(u16, (__bf16)x); }
DI float bf2f(u16 v) { return __uint_as_float(((unsigned)v) << 16); }
DI unsigned pack2(float a, float b) { f32x2_t v = {a, b}; return __builtin_bit_cast(unsigned, __builtin_convertvector(v, bf16x2_t)); }
DI float lo2f(unsigned u) { return __uint_as_float(u << 16); }
DI float hi2f(unsigned u) { return __uint_as_float(u & 0xffff0000u); }
DI f32x4 mfma(bf16x8 a, bf16x8 b, f32x4 c) { return __builtin_amdgcn_mfma_f32_16x16x32_bf16(a, b, c, 0, 0, 0); }
DI bf16x8 ldfrag(const u16* ptr) { return *(const bf16x8*)ptr; }
DI float4 ntload4(const float4* ptr) { f32x4 v = __builtin_nontemporal_load((const f32x4*)ptr); return make_float4(v[0], v[1], v[2], v[3]); }
DI void ntstore4(float4* ptr, float4 v) { f32x4 t = {v.x, v.y, v.z, v.w}; __builtin_nontemporal_store(t, (f32x4*)ptr); }
DI float silu(float x) { return x / (1.f + __expf(-x)); }
DI void st4bf(u16* dst, float a, float b, float c, float d) { uint2 v; v.x = pack2(a, b); v.y = pack2(c, d); *(uint2*)dst = v; }
DI void ld4bf(const u16* src, float* o) { uint2 v = *(const uint2*)src; o[0] = lo2f(v.x); o[1] = hi2f(v.x); o[2] = lo2f(v.y); o[3] = hi2f(v.y); }
DI void ld8bf(const u16* src, float* o) { uint4 v = *(const uint4*)src; o[0] = lo2f(v.x); o[1] = hi2f(v.x); o[2] = lo2f(v.y); o[3] = hi2f(v.y); o[4] = lo2f(v.z); o[5] = hi2f(v.z); o[6] = lo2f(v.w); o[7] = hi2f(v.w); }
DI float wave_sum(float v) { for (int o = 32; o > 0; o >>= 1) v += __shfl_xor(v, o); return v; }
DI float grp16_sum(float v) { v += __shfl_xor(v, 1); v += __shfl_xor(v, 2); v += __shfl_xor(v, 4); v += __shfl_xor(v, 8); return v; }

DI float xmax16(float v) { auto r = __builtin_amdgcn_permlane16_swap(__float_as_uint(v), __float_as_uint(v), false, false); return fmaxf(__uint_as_float(r[0]), __uint_as_float(r[1])); }
DI float xmax32(float v) { auto r = __builtin_amdgcn_permlane32_swap(__float_as_uint(v), __float_as_uint(v), false, false); return fmaxf(__uint_as_float(r[0]), __uint_as_float(r[1])); }
DI float xsum16(float v) { auto r = __builtin_amdgcn_permlane16_swap(__float_as_uint(v), __float_as_uint(v), false, false); return __uint_as_float(r[0]) + __uint_as_float(r[1]); }
DI float xsum32(float v) { auto r = __builtin_amdgcn_permlane32_swap(__float_as_uint(v), __float_as_uint(v), false, false); return __uint_as_float(r[0]) + __uint_as_float(r[1]); }

DI float wave_incl_scan(float v, int lane) {
#pragma unroll
  for (int o = 1; o < 64; o <<= 1) { const float t = __shfl_up(v, o); if (lane >= o) v += t; }
  return v;
}

struct TI { int t0, n0, N, isctx, b, kvoff, nk, kvrow0, c, nc; };
DI TI tile_info(int tt) {
  TI t; t.t0 = tt * 64;
  if (tt < 128) { int seq = tt >> 2; t.n0 = (tt & 3) * 64; t.N = 256; t.isctx = 1; t.b = seq; t.kvoff = seq * 256; t.nk = 256; t.kvrow0 = t.kvoff + t.n0; }
  else { int q = tt - 128; t.b = q >> 5; t.n0 = (q & 31) * 64; t.N = 2048; t.isctx = 0; t.kvoff = 8192 + t.b * 2560; t.nk = 2560; t.kvrow0 = t.kvoff + 512 + t.n0; }
  t.c = t.n0 >> 6; t.nc = t.N >> 6;
  return t;
}

DI void p0_mod(const P& p, int job, char* smem) {
  float* sl = (float*)smem; float* red = sl + 3072;
  const int tid = otid();
#pragma unroll
  for (int i = 0; i < 12; ++i) {
    const int e = tid + 256 * i; const int cnd = e >> 10, k = e & 1023;
    const float v = cnd == 0 ? p.in[9][k] : p.in[2][(cnd - 1) * 1024 + k];
    sl[e] = silu(v);
  }
  __syncthreads();
  const int l = job / 192, c0 = (job % 192) * 16;
  const int ks = tid >> 2, cq = tid & 3;
  const float* w = p.in[10] + (size_t)l * 1024 * 3072 + c0 + cq * 4;
  f32x4 a0 = {0.f, 0.f, 0.f, 0.f}, a1 = a0, a2 = a0;
#pragma unroll
  for (int kk = 0; kk < 16; ++kk) {
    const int k = ks * 16 + kk;
    const f32x4 wv = __builtin_nontemporal_load((const f32x4*)(w + (size_t)k * 3072));
    a0 += wv * sl[k]; a1 += wv * sl[1024 + k]; a2 += wv * sl[2048 + k];
  }
  *(f32x4*)(red + (ks * 3 + 0) * 16 + cq * 4) = a0; *(f32x4*)(red + (ks * 3 + 1) * 16 + cq * 4) = a1; *(f32x4*)(red + (ks * 3 + 2) * 16 + cq * 4) = a2;
  __syncthreads();
  if (tid < 48) {
    const int cnd = tid >> 4, c2 = tid & 15; float s2 = 0;
#pragma unroll 8
    for (int k2 = 0; k2 < 64; ++k2) s2 += red[(k2 * 3 + cnd) * 16 + c2];
    s2 += p.in[11][l * 3072 + c0 + c2];
    ((float*)(p.ws + WS_MOD))[(l * 3 + cnd) * 3072 + c0 + c2] = s2;
  }
  __syncthreads();
}

DI void p0_transpose(const float* src, int K, int N, u16* dst, int tk, int tn, char* smem) {
  float* tile = (float*)smem;
  const int tid = otid(); const int k0 = tk * 64, n0 = tn * 64;
  f32x4 v[4];
#pragma unroll
  for (int i = 0; i < 4; ++i) {
    const int k = i * 16 + (tid >> 4), n = (tid & 15) * 4;
    v[i] = (n0 + n < N) ? __builtin_nontemporal_load((const f32x4*)(src + (size_t)(k0 + k) * N + n0 + n)) : (f32x4){0.f, 0.f, 0.f, 0.f};
  }
#pragma unroll
  for (int i = 0; i < 4; ++i) {
    const int k = i * 16 + (tid >> 4), n = (tid & 15) * 4;
    tile[k * 65 + n] = v[i][0]; tile[k * 65 + n + 1] = v[i][1]; tile[k * 65 + n + 2] = v[i][2]; tile[k * 65 + n + 3] = v[i][3];
  }
  __syncthreads();
  {
    const int n = tid >> 2, kq = (tid & 3) * 16;
    u32x4 o0, o1;
#pragma unroll
    for (int e = 0; e < 4; ++e) {
      o0[e] = pack2(tile[(kq + 2 * e) * 65 + n], tile[(kq + 2 * e + 1) * 65 + n]);
      o1[e] = pack2(tile[(kq + 8 + 2 * e) * 65 + n], tile[(kq + 8 + 2 * e + 1) * 65 + n]);
    }
    u16* d = dst + (size_t)(n0 + n) * K + k0 + kq;
    *(u32x4*)d = o0; *(u32x4*)(d + 8) = o1;
  }
  __syncthreads();
}

DI void phase0(const P& p, char* smem) {
  for (int job = blockIdx.x; job < 2500; job += gridDim.x) {
    if (job < 384) p0_mod(p, job, smem);
    else if (job < 384 + 1536) { int j = job - 384; int l = j / 768, r = j % 768; p0_transpose(p.in[14] + (size_t)l * 1024 * 2952, 1024, 2952, (u16*)(p.ws + WS_WINT) + (size_t)l * 3072 * 1024, r / 48, r % 48, smem); }
    else if (job < 1920 + 512) { int j = job - 1920; int l = j >> 8, r = j & 255; p0_transpose(p.in[15] + (size_t)l * 1024 * 1024, 1024, 1024, (u16*)(p.ws + WS_WOUTT) + (size_t)l * 1024 * 1024, r >> 4, r & 15, smem); }
    else if (job < 2432 + 36) { int j = job - 2432; int l = j / 18, r = j % 18; p0_transpose(p.in[23] + (size_t)l * 192 * 384, 192, 384, (u16*)(p.ws + WS_WUQT) + (size_t)l * 384 * 192, r / 6, r % 6, smem); }
    else { int j = job - 2468; int l = j >> 4, r = j & 15; p0_transpose(p.in[24] + (size_t)l * 128 * 512, 128, 512, (u16*)(p.ws + WS_WUKVT) + (size_t)l * 512 * 128, r >> 3, r & 7, smem); }
  }
}

DI void phaseA(const P& p, int l) {
  const int tidA = otid();
  const int lane = tidA & 63;
  const int gw = blockIdx.x * 4 + (tidA >> 6), nw = gridDim.x * 4;
  const float* MOD = (const float*)(p.ws + WS_MOD);
  const u16* O = (const u16*)(p.ws + WS_U);
  u16* H = (u16*)(p.ws + WS_H);
  float4 xn[4]; uint2 on[4];
  {
    const int row = gw;
    if (row < 12288) {
      const float* xin = (l <= 1) ? (row < 8192 ? p.in[0] + (size_t)row * 1024 : p.in[1] + (size_t)(row - 8192) * 1024) : p.out + (size_t)row * 1024;
#pragma unroll
      for (int i = 0; i < 4; ++i) { xn[i] = ntload4(((const float4*)xin) + i * 64 + lane); if (l > 0) on[i] = ((const uint2*)(O + (size_t)row * 1024))[i * 64 + lane]; }
    }
  }
  for (int row = gw; row < 12288; row += nw) {
    const int cond = row < 8192 ? 0 : 1 + ((row - 8192) >> 11);
    float4 x[4], o[4];
#pragma unroll
    for (int i = 0; i < 4; ++i) { x[i] = xn[i]; o[i] = make_float4(lo2f(on[i].x), hi2f(on[i].x), lo2f(on[i].y), hi2f(on[i].y)); }
    {
      const int rown = row + nw;
      if (rown < 12288) {
        const float* xin = (l <= 1) ? (rown < 8192 ? p.in[0] + (size_t)rown * 1024 : p.in[1] + (size_t)(rown - 8192) * 1024) : p.out + (size_t)rown * 1024;
#pragma unroll
        for (int i = 0; i < 4; ++i) { xn[i] = ntload4(((const float4*)xin) + i * 64 + lane); if (l > 0) on[i] = ((const uint2*)(O + (size_t)rown * 1024))[i * 64 + lane]; }
      }
    }
    if (l > 0) {
      float ss = 0;
#pragma unroll
      for (int i = 0; i < 4; ++i) ss += o[i].x * o[i].x + o[i].y * o[i].y + o[i].z * o[i].z + o[i].w * o[i].w;
      ss = wave_sum(ss);
      const float rr = rsqrtf(ss * (1.f / 1024.f) + EPS);
      const float* gate = MOD + ((l - 1) * 3 + cond) * 3072 + 2048;
      const float* np = p.in[13] + (l - 1) * 1024;
#pragma unroll
      for (int i = 0; i < 4; ++i) {
        float4 g4 = ((const float4*)gate)[i * 64 + lane], n4 = ((const float4*)np)[i * 64 + lane];
        x[i].x += g4.x * (o[i].x * rr * n4.x); x[i].y += g4.y * (o[i].y * rr * n4.y);
        x[i].z += g4.z * (o[i].z * rr * n4.z); x[i].w += g4.w * (o[i].w * rr * n4.w);
        ntstore4(((float4*)(p.out + (size_t)row * 1024)) + i * 64 + lane, x[i]);
      }
    }
    if (l < 2) {
      float ss = 0;
#pragma unroll
      for (int i = 0; i < 4; ++i) ss += x[i].x * x[i].x + x[i].y * x[i].y + x[i].z * x[i].z + x[i].w * x[i].w;
      ss = wave_sum(ss);
      const float rr = rsqrtf(ss * (1.f / 1024.f) + EPS);
      const float* sh = MOD + (l * 3 + cond) * 3072; const float* sc = sh + 1024;
      const float* np = p.in[12] + l * 1024;
#pragma unroll
      for (int i = 0; i < 4; ++i) {
        float4 s4 = ((const float4*)sh)[i * 64 + lane], c4 = ((const float4*)sc)[i * 64 + lane], n4 = ((const float4*)np)[i * 64 + lane];
        st4bf(H + (size_t)row * 1024 + i * 256 + lane * 4,
              x[i].x * rr * n4.x * (1.f + c4.x) + s4.x, x[i].y * rr * n4.y * (1.f + c4.y) + s4.y,
              x[i].z * rr * n4.z * (1.f + c4.z) + s4.z, x[i].w * rr * n4.w * (1.f + c4.w) + s4.w);
      }
    }
  }
}

template <int MODE>
DI void gemm_tile(const u16* __restrict__ A, const u16* __restrict__ Bt, int mt, int nt, char* cout, float* side, char* smem) {
  u16* As = (u16*)smem;
  const int tid = otid(), lane = tid & 63, w = tid >> 6, r = lane & 15, g = lane >> 4;
  const int wm = w & 1, wn = w >> 1;
  constexpr int TI = MODE == 1 ? 3 : 4;
  constexpr int BMT = TI * 32, WMT = TI * 16;
  const u16* Ag = A + (size_t)(mt * BMT) * 1024;
  const u16* Bg = Bt + (size_t)(nt * 128) * 1024;
  f32x4 acc[4][TI];
#pragma unroll
  for (int i = 0; i < 4; ++i)
#pragma unroll
    for (int j = 0; j < TI; ++j) acc[i][j] = (f32x4){0.f, 0.f, 0.f, 0.f};
  u32x4 ra[2][TI], rb[2][4];
  float rrow[TI];
  if (MODE == 1) {
#pragma unroll
    for (int ti = 0; ti < TI; ++ti) { const float2 q = *(const float2*)(side + (size_t)(mt * BMT + wm * WMT + ti * 16 + r) * 2); rrow[ti] = rsqrtf((q.x + q.y) * (1.f / 256.f) + EPS); }
  }
  const int lrow = tid >> 3, lch = (tid & 7) * 8;
  const int lsw = ((tid & 7) ^ ((lrow >> 1) & 7)) * 8;
  const int rsw = (r >> 1) & 7;
#define G_LOAD(SET, KT) { _Pragma("unroll") for (int i = 0; i < 4; ++i) { if (i < TI) ra[SET][i < TI ? i : 0] = *(const u32x4*)(Ag + (size_t)(lrow + 32 * i) * 1024 + (KT) * 64 + lch); rb[SET][i] = *(const u32x4*)(Bg + (size_t)(lrow + 32 * i) * 1024 + (KT) * 64 + lch); } }
#define G_STORE(SET, BUFI) { u16* as_ = As + (BUFI) * (256 * 64); u16* bs_ = as_ + 128 * 64; _Pragma("unroll") for (int i = 0; i < 4; ++i) { if (i < TI) *(u32x4*)(as_ + (lrow + 32 * i) * 64 + lsw) = ra[SET][i < TI ? i : 0]; *(u32x4*)(bs_ + (lrow + 32 * i) * 64 + lsw) = rb[SET][i]; } }
#define G_COMPUTE(BUFI) { const u16* as_ = As + (BUFI) * (256 * 64); const u16* bs_ = as_ + 128 * 64; \
    _Pragma("unroll") for (int s = 0; s < 2; ++s) { bf16x8 wf[4], xf[TI]; const int co = ((s * 4 + g) ^ rsw) * 8; \
      _Pragma("unroll") for (int i = 0; i < 4; ++i) { wf[i] = ldfrag(bs_ + (wn * 64 + i * 16 + r) * 64 + co); if (i < TI) xf[i < TI ? i : 0] = ldfrag(as_ + (wm * WMT + i * 16 + r) * 64 + co); } \
      __builtin_amdgcn_s_setprio(1); \
      _Pragma("unroll") for (int ni = 0; ni < 4; ++ni) _Pragma("unroll") for (int ti = 0; ti < TI; ++ti) acc[ni][ti] = mfma(wf[ni], xf[ti], acc[ni][ti]); \
      __builtin_amdgcn_s_setprio(0); } }
  G_LOAD(0, 0)
  G_LOAD(1, 1)
  G_STORE(0, 0)
  __syncthreads();
  for (int kt = 0; kt < 16; kt += 2) {
    if (MODE == 1 && kt == 12) {
#pragma unroll
      for (int ni = 0; ni < 4; ++ni)
#pragma unroll
        for (int ti = 0; ti < TI; ++ti) acc[ni][ti] = acc[ni][ti] * (1.f / rrow[ti]);
    }
    if (kt + 2 < 16) G_LOAD(0, kt + 2)
    G_COMPUTE(0)
    G_STORE(1, 1)
    __syncthreads();
    if (kt + 3 < 16) G_LOAD(1, kt + 3)
    G_COMPUTE(1)
    if (kt + 2 < 16) G_STORE(0, 0)
    __syncthreads();
  }
#undef G_LOAD
#undef G_STORE
#undef G_COMPUTE
  u16* Cs = (u16*)smem;
#pragma unroll
  for (int ni = 0; ni < 4; ++ni)
#pragma unroll
    for (int ti = 0; ti < TI; ++ti) {
      f32x4 v = acc[ni][ti];
      if (MODE == 0) {
        const int tok = mt * BMT + wm * WMT + ti * 16 + r;
        const int n = nt * 128 + wn * 64 + ni * 16 + g * 4;
        if (n >= 1280 && n < 1312) *(float4*)(side + (size_t)tok * 40 + (n - 1280)) = make_float4(v[0], v[1], v[2], v[3]);
        if (n >= 2944 && n < 2952) *(float4*)(side + (size_t)tok * 40 + 32 + (n - 2944)) = make_float4(v[0], v[1], v[2], v[3]);
      } else {
        v = v * rrow[ti];
      }
      st4bf(Cs + (wm * WMT + ti * 16 + r) * 136 + wn * 64 + ni * 16 + g * 4, v[0], v[1], v[2], v[3]);
    }
  __syncthreads();
  {
    constexpr int LDC = MODE == 0 ? 3072 : 1024;
    u16* outp = (u16*)cout + (size_t)(mt * BMT) * LDC + nt * 128;
#pragma unroll
    for (int i = 0; i < TI * 2; ++i) {
      const int idx = tid + 256 * i, row = idx >> 4, chk = idx & 15;
      *(u32x4*)(outp + (size_t)row * LDC + chk * 8) = *(const u32x4*)(Cs + row * 136 + chk * 8);
    }
  }
  __syncthreads();
}

DI void vt_store_tile(const u16* tile, u16* vt_base, int nk, int key0) {
  const int tid = otid(), seg = tid & 7;
#pragma unroll
  for (int it = 0; it < 4; ++it) {
    const int c = it * 32 + (tid >> 3);
    u32x4 o;
#pragma unroll
    for (int e = 0; e < 4; ++e) o[e] = (unsigned)tile[(seg * 8 + 2 * e) * 136 + c] | ((unsigned)tile[(seg * 8 + 2 * e + 1) * 136 + c] << 16);
    *(u32x4*)(vt_base + (size_t)c * nk + key0 + seg * 8) = o;
  }
}

DI void c_gqa(const P& p, int l, int tt, char* smem) {
  const TI ti = tile_info(tt);
  const u16* U = (const u16*)(p.ws + WS_U);
  u16* Qg = (u16*)(p.ws + WS_QG); u16* Kg = (u16*)(p.ws + WS_KG); u16* VgT = (u16*)(p.ws + WS_VGT);
  const int tid = otid(), grp = tid >> 4, li = tid & 15;
  const float* qn = p.in[16] + l * 64; const float* kn = p.in[17] + l * 64;
  for (int itb = 0; itb < 24; itb += 4) {
    uint2 xraw[4];
#pragma unroll
    for (int k = 0; k < 4; ++k) { const int u = (itb + k) * 16 + grp; xraw[k] = *(const uint2*)(U + (size_t)(ti.t0 + u / 6) * 3072 + (u % 6) * 64 + li * 4); }
#pragma unroll
    for (int k = 0; k < 4; ++k) {
      const int u = (itb + k) * 16 + grp; const int tok = u / 6, hh = u % 6;
      const int t = ti.t0 + tok, n = ti.n0 + tok;
      float x[4] = {lo2f(xraw[k].x), hi2f(xraw[k].x), lo2f(xraw[k].y), hi2f(xraw[k].y)};
      float ss = x[0] * x[0] + x[1] * x[1] + x[2] * x[2] + x[3] * x[3];
      ss = grp16_sum(ss);
      const float rr = rsqrtf(ss * (1.f / 64.f) + EPS);
      const float* gn = hh < 4 ? qn : kn;
      float y[4];
#pragma unroll
      for (int i = 0; i < 4; ++i) y[i] = x[i] * rr * gn[li * 4 + i];
      if (hh >= 4 && ti.isctx) *(float4*)(p.out + OUT_GK + ((size_t)((ti.b * 2 + l) * 256 + n) * 2 + (hh - 4)) * 64 + li * 4) = make_float4(y[0], y[1], y[2], y[3]);
      if (!ti.isctx) {
        const int axis = li >> 3, half = (li >> 2) & 1;
        const float pos = (float)(axis == 0 ? (n >> 6) : (n & 63));
#pragma unroll
        for (int i = 0; i < 4; ++i) {
          const int f = (li & 3) * 4 + i;
          const float ang = pos * exp2f(-(float)f * 0.83048202372f);
          const float cs = __cosf(ang), sn = __sinf(ang);
          const float pr = __shfl_xor(y[i], 4);
          y[i] = half == 0 ? y[i] * cs - pr * sn : y[i] * cs + pr * sn;
        }
      }
      if (hh < 4) st4bf(Qg + (size_t)t * 256 + hh * 64 + li * 4, y[0] * QSC_G, y[1] * QSC_G, y[2] * QSC_G, y[3] * QSC_G);
      else st4bf(Kg + (size_t)(ti.kvrow0 + tok) * 128 + (hh - 4) * 64 + li * 4, y[0], y[1], y[2], y[3]);
    }
  }
  {
    u16* tile = (u16*)smem;
    const int tok = tid >> 2, cq = tid & 3; const int t = ti.t0 + tok, n = ti.n0 + tok;
    u32x4 vraw[4];
#pragma unroll
    for (int j4 = 0; j4 < 4; ++j4) vraw[j4] = *(const u32x4*)(U + (size_t)t * 3072 + 384 + cq * 32 + j4 * 8);
#pragma unroll
    for (int j4 = 0; j4 < 4; ++j4) {
      *(u32x4*)(tile + tok * 136 + cq * 32 + j4 * 8) = vraw[j4];
      if (ti.isctx) {
        float* o = p.out + OUT_GV + (size_t)((ti.b * 2 + l) * 256 + n) * 128 + cq * 32 + j4 * 8;
        *(float4*)o = make_float4(lo2f(vraw[j4][0]), hi2f(vraw[j4][0]), lo2f(vraw[j4][1]), hi2f(vraw[j4][1]));
        *(float4*)(o + 4) = make_float4(lo2f(vraw[j4][2]), hi2f(vraw[j4][2]), lo2f(vraw[j4][3]), hi2f(vraw[j4][3]));
      }
    }
    __syncthreads();
    vt_store_tile(tile, VgT + (size_t)ti.kvoff * 128, ti.nk, ti.kvrow0 - ti.kvoff);
    __syncthreads();
  }
}

DI void mla_kv_up(const u16* Ackv, const u16* __restrict__ WukvT, u16* Km, u16* VmT, int kvrow0, int kvoff, int nk) {
  const int tid = otid(), lane = tid & 63, w = tid >> 6, r = lane & 15, g = lane >> 4;
  const int h = w;
  bf16x8 wn[4];
#pragma unroll
  for (int s = 0; s < 4; ++s) wn[s] = ldfrag(WukvT + (size_t)(h * 128 + r) * 128 + s * 32 + g * 8);
  for (int sub = 0; sub < 8; ++sub) {
    bf16x8 wf[4];
#pragma unroll
    for (int s = 0; s < 4; ++s) wf[s] = wn[s];
    if (sub < 7) {
#pragma unroll
      for (int s = 0; s < 4; ++s) wn[s] = ldfrag(WukvT + (size_t)(h * 128 + (sub + 1) * 16 + r) * 128 + s * 32 + g * 8);
    }
#pragma unroll
    for (int t4 = 0; t4 < 4; ++t4) {
      f32x4 acc = (f32x4){0.f, 0.f, 0.f, 0.f};
      if (sub < 4) {
#pragma unroll
        for (int s = 0; s < 4; ++s) acc = mfma(wf[s], ldfrag(Ackv + (t4 * 16 + r) * 136 + s * 32 + g * 8), acc);
        st4bf(Km + (size_t)(kvrow0 + t4 * 16 + r) * 384 + h * 96 + sub * 16 + g * 4, acc[0], acc[1], acc[2], acc[3]);
      } else {
#pragma unroll
        for (int s = 0; s < 4; ++s) acc = mfma(ldfrag(Ackv + (t4 * 16 + r) * 136 + s * 32 + g * 8), wf[s], acc);
        const int dv = (sub - 4) * 16 + r;
        st4bf(VmT + (size_t)kvoff * 256 + (size_t)(h * 64 + dv) * nk + (kvrow0 - kvoff) + t4 * 16 + g * 4, acc[0], acc[1], acc[2], acc[3]);
      }
    }
  }
}

DI void c_mla_q(const P& p, int l, int tt, char* smem) {
  const TI ti = tile_info(tt);
  const u16* U = (const u16*)(p.ws + WS_U);
  u16* Qm = (u16*)(p.ws + WS_QM);
  u16* Acq = (u16*)smem;
  const int tid = otid(), grp = tid >> 4, li = tid & 15;
  const float* qn = p.in[21] + l * 192;
  {
    uint2 raw[4][3];
#pragma unroll
    for (int it = 0; it < 4; ++it)
#pragma unroll
      for (int k = 0; k < 3; ++k) raw[it][k] = *(const uint2*)(U + (size_t)(ti.t0 + it * 16 + grp) * 3072 + 1568 + li * 12 + k * 4);
#pragma unroll
    for (int it = 0; it < 4; ++it) {
      const int tok = it * 16 + grp;
      float x[12];
#pragma unroll
      for (int k = 0; k < 3; ++k) { x[k * 4] = lo2f(raw[it][k].x); x[k * 4 + 1] = hi2f(raw[it][k].x); x[k * 4 + 2] = lo2f(raw[it][k].y); x[k * 4 + 3] = hi2f(raw[it][k].y); }
      float ss = 0;
#pragma unroll
      for (int i = 0; i < 12; ++i) ss += x[i] * x[i];
      ss = grp16_sum(ss);
      const float rr = rsqrtf(ss * (1.f / 192.f) + EPS);
#pragma unroll
      for (int i = 0; i < 12; i += 4) st4bf(Acq + tok * 200 + li * 12 + i, x[i] * rr * qn[li * 12 + i], x[i + 1] * rr * qn[li * 12 + i + 1], x[i + 2] * rr * qn[li * 12 + i + 2], x[i + 3] * rr * qn[li * 12 + i + 3]);
    }
  }
  __syncthreads();
  {
    const int lane = tid & 63, w = tid >> 6, r = lane & 15, g = lane >> 4;
    const u16* WuqT = (const u16*)(p.ws + WS_WUQT) + (size_t)l * 384 * 192;
    bf16x8 wn[6];
#pragma unroll
    for (int s = 0; s < 6; ++s) wn[s] = ldfrag(WuqT + (size_t)(w * 96 + r) * 192 + s * 32 + g * 8);
    for (int sub = 0; sub < 6; ++sub) {
      bf16x8 wf[6];
#pragma unroll
      for (int s = 0; s < 6; ++s) wf[s] = wn[s];
      if (sub < 5) {
#pragma unroll
        for (int s = 0; s < 6; ++s) wn[s] = ldfrag(WuqT + (size_t)(w * 96 + (sub + 1) * 16 + r) * 192 + s * 32 + g * 8);
      }
#pragma unroll
      for (int t4 = 0; t4 < 4; ++t4) {
        f32x4 acc = (f32x4){0.f, 0.f, 0.f, 0.f};
#pragma unroll
        for (int s = 0; s < 6; ++s) acc = mfma(wf[s], ldfrag(Acq + (t4 * 16 + r) * 200 + s * 32 + g * 8), acc);
        float y[4] = {acc[0], acc[1], acc[2], acc[3]};
        if (sub >= 4 && !ti.isctx) {
          const int n = ti.n0 + t4 * 16 + r;
          const int axis = sub - 4, half = g >> 1;
          const float pos = (float)(axis == 0 ? (n >> 6) : (n & 63));
#pragma unroll
          for (int i = 0; i < 4; ++i) {
            const int f = (g & 1) * 4 + i;
            const float ang = pos * exp2f(-(float)f * 1.66096404744f);
            const float cs = __cosf(ang), sn = __sinf(ang);
            const float pr = __shfl_xor(y[i], 32);
            y[i] = half == 0 ? y[i] * cs - pr * sn : y[i] * cs + pr * sn;
          }
        }
        const float sc = 0.10206207262f * 1.44269504089f;
        st4bf(Qm + (size_t)(ti.t0 + t4 * 16 + r) * 384 + w * 96 + sub * 16 + g * 4, y[0] * sc, y[1] * sc, y[2] * sc, y[3] * sc);
      }
    }
  }
  __syncthreads();
}

DI void c_mla_kv(const P& p, int l, int tt, char* smem) {
  const TI ti = tile_info(tt);
  const u16* U = (const u16*)(p.ws + WS_U);
  u16* Km = (u16*)(p.ws + WS_KM); u16* VmT = (u16*)(p.ws + WS_VMT);
  u16* Ackv = (u16*)smem;
  const int tid = otid(), grp = tid >> 4, li = tid & 15;
  const float* kvn = p.in[22] + l * 128;
  {
    u32x4 rawc[4]; unsigned rawk[4];
#pragma unroll
    for (int it = 0; it < 4; ++it) {
      rawc[it] = *(const u32x4*)(U + (size_t)(ti.t0 + it * 16 + grp) * 3072 + 1760 + li * 8);
      rawk[it] = *(const unsigned*)(U + (size_t)(ti.t0 + it * 16 + grp) * 3072 + 1888 + li * 2);
    }
#pragma unroll
    for (int it = 0; it < 4; ++it) {
      const int tok = it * 16 + grp; const int n = ti.n0 + tok;
      {
        float x[8];
#pragma unroll
        for (int e = 0; e < 4; ++e) { x[e * 2] = lo2f(rawc[it][e]); x[e * 2 + 1] = hi2f(rawc[it][e]); }
        float ss = 0;
#pragma unroll
        for (int i = 0; i < 8; ++i) ss += x[i] * x[i];
        ss = grp16_sum(ss);
        const float rr = rsqrtf(ss * (1.f / 128.f) + EPS);
#pragma unroll
        for (int i = 0; i < 8; ++i) x[i] = x[i] * rr * kvn[li * 8 + i];
        if (ti.isctx) { float* o = p.out + OUT_CKV + (size_t)((ti.b * 2 + l) * 256 + n) * 128 + li * 8; *(float4*)o = make_float4(x[0], x[1], x[2], x[3]); *(float4*)(o + 4) = make_float4(x[4], x[5], x[6], x[7]); }
        st4bf(Ackv + tok * 136 + li * 8, x[0], x[1], x[2], x[3]); st4bf(Ackv + tok * 136 + li * 8 + 4, x[4], x[5], x[6], x[7]);
      }
      {
        float y[2] = {lo2f(rawk[it]), hi2f(rawk[it])};
        if (ti.isctx) *(float2*)(p.out + OUT_KR + (size_t)((ti.b * 2 + l) * 256 + n) * 32 + li * 2) = make_float2(y[0], y[1]);
        else {
          const int axis = li >> 3, half = (li >> 2) & 1;
          const float pos = (float)(axis == 0 ? (n >> 6) : (n & 63));
#pragma unroll
          for (int e = 0; e < 2; ++e) {
            const int f = (li & 3) * 2 + e;
            const float ang = pos * exp2f(-(float)f * 1.66096404744f);
            const float cs = __cosf(ang), sn = __sinf(ang);
            const float pr = __shfl_xor(y[e], 4);
            y[e] = half == 0 ? y[e] * cs - pr * sn : y[e] * cs + pr * sn;
          }
        }
        const unsigned pk = pack2(y[0], y[1]);
#pragma unroll
        for (int h = 0; h < 4; ++h) *(unsigned*)(Km + (size_t)(ti.kvrow0 + tok) * 384 + h * 96 + 64 + li * 2) = pk;
      }
    }
  }
  __syncthreads();
  mla_kv_up(Ackv, (const u16*)(p.ws + WS_WUKVT) + (size_t)l * 512 * 128, Km, VmT, ti.kvrow0, ti.kvoff, ti.nk);
  __syncthreads();
}

DI void c_cache(const P& p, int l, int job, char* smem) {
  const int b = job >> 3, j0 = (job & 7) * 64;
  const int kvoff = 8192 + b * 2560, nk = 2560, kvrow0 = kvoff + j0;
  u16* Kg = (u16*)(p.ws + WS_KG); u16* VgT = (u16*)(p.ws + WS_VGT); u16* Km = (u16*)(p.ws + WS_KM); u16* VmT = (u16*)(p.ws + WS_VMT);
  u16* Ackv = (u16*)smem;
  const int tid = otid(), grp = tid >> 4, li = tid & 15;
  const size_t cbase = (size_t)(b * 2 + l) * 512 + j0;
  for (int it = 0; it < 4; ++it) {
    const int tok = it * 16 + grp;
    const float* src = p.in[5] + (cbase + tok) * 128 + li * 8;
    float4 a = *(const float4*)src, c = *(const float4*)(src + 4);
    st4bf(Ackv + tok * 136 + li * 8, a.x, a.y, a.z, a.w); st4bf(Ackv + tok * 136 + li * 8 + 4, c.x, c.y, c.z, c.w);
    float2 kr = *(const float2*)(p.in[6] + (cbase + tok) * 32 + li * 2);
    const unsigned pk = pack2(kr.x, kr.y);
#pragma unroll
    for (int h = 0; h < 4; ++h) *(unsigned*)(Km + (size_t)(kvrow0 + tok) * 384 + h * 96 + 64 + li * 2) = pk;
  }
  u16* vtile = Ackv + 64 * 136;
#pragma unroll
  for (int i = 0; i < 8; ++i) {
    const int idx = tid + 256 * i, row = idx >> 5, c4 = (idx & 31) * 4;
    const float4 kv = *(const float4*)(p.in[3] + (cbase + row) * 128 + c4);
    st4bf(Kg + (size_t)(kvrow0 + row) * 128 + c4, kv.x, kv.y, kv.z, kv.w);
    const float4 vv = *(const float4*)(p.in[4] + (cbase + row) * 128 + c4);
    st4bf(vtile + row * 136 + c4, vv.x, vv.y, vv.z, vv.w);
  }
  __syncthreads();
  vt_store_tile(vtile, VgT + (size_t)kvoff * 128, nk, j0);
  mla_kv_up(Ackv, (const u16*)(p.ws + WS_WUKVT) + (size_t)l * 512 * 128, Km, VmT, kvrow0, kvoff, nk);
  __syncthreads();
}

DI void gla_logg_cum(const P& p, int l, int t0, int h, float* CB, float* TT) {
  const int tid = otid(), tok = tid >> 2, dsub = tid & 3;
  const float* SIDE = (const float*)(p.ws + WS_SIDE);
  for (int dir = 0; dir < 2; ++dir) {
    const float* gl = SIDE + (size_t)(t0 + tok) * 40 + dir * 16;
    float glr[16];
#pragma unroll
    for (int i = 0; i < 4; ++i) { float4 v = ((const float4*)gl)[i]; glr[i * 4] = v.x; glr[i * 4 + 1] = v.y; glr[i * 4 + 2] = v.z; glr[i * 4 + 3] = v.w; }
    float acc[8];
    const float* bg = p.in[19] + (l * 2 + dir) * 128 + h * 32 + dsub * 8;
#pragma unroll
    for (int e = 0; e < 8; ++e) acc[e] = bg[e];
#pragma unroll
    for (int r = 0; r < 16; ++r) {
      const float* wr = p.in[18] + (size_t)((l * 2 + dir) * 16 + r) * 128 + h * 32 + dsub * 8;
      float4 w0 = *(const float4*)wr, w1 = *(const float4*)(wr + 4);
      acc[0] += glr[r] * w0.x; acc[1] += glr[r] * w0.y; acc[2] += glr[r] * w0.z; acc[3] += glr[r] * w0.w;
      acc[4] += glr[r] * w1.x; acc[5] += glr[r] * w1.y; acc[6] += glr[r] * w1.z; acc[7] += glr[r] * w1.w;
    }
#pragma unroll
    for (int e = 0; e < 8; ++e) {
      const float x = acc[e];
      const float ls = fminf(x, 0.f) - 0.69314718056f * __log2f(1.f + __builtin_amdgcn_exp2f(-1.44269504089f * fabsf(x)));
      CB[(dir * 64 + tok) * 32 + dsub * 8 + e] = ls * (1.f / 16.f);
    }
  }
  __syncthreads();
  {
    const int lane = tid & 63, w = tid >> 6;
#pragma unroll 4
    for (int i = 0; i < 16; ++i) {
      const int col = w * 16 + i, dir = col >> 5, d = col & 31;
      const int j = dir ? 63 - lane : lane;
      float v = CB[(dir * 64 + j) * 32 + d];
      v = wave_incl_scan(v, lane);
      CB[(dir * 64 + j) * 32 + d] = v;
      if (lane == 63) TT[col] = v;
    }
  }
  __syncthreads();
}

DI void c_gla(const P& p, int l, int tt, int h, char* smem) {
  const int t0 = tt * 64;
  float* CB = (float*)smem; float* TT = CB + 4096;
  u16* KoutT = (u16*)(TT + 64); u16* VT = KoutT + 64 * 72;
  const u16* U = (const u16*)(p.ws + WS_U);
  const int tid = otid();
  gla_logg_cum(p, l, t0, h, CB, TT);
  {
    float* dst = (float*)(p.ws + WS_CBG) + (size_t)(tt * 4 + h) * 4160;
#pragma unroll
    for (int i = 0; i < 4; ++i) *(float4*)(dst + (tid + 256 * i) * 4) = *(const float4*)(CB + (tid + 256 * i) * 4);
    if (tid < 16) *(float4*)(dst + 4096 + tid * 4) = *(const float4*)(TT + tid * 4);
  }
  {
    const int tok = tid >> 2, sub = tid & 3;
    float k[8]; ld8bf(U + (size_t)(t0 + tok) * 3072 + 896 + h * 32 + sub * 8, k);
#pragma unroll
    for (int dir = 0; dir < 2; ++dir)
#pragma unroll
      for (int e = 0; e < 8; ++e) { const int d = sub * 8 + e; KoutT[(dir * 32 + d) * 72 + tok] = f2bf(k[e] * __expf(TT[dir * 32 + d] - CB[(dir * 64 + tok) * 32 + d])); }
    const u16* vs = U + (size_t)(t0 + tok) * 3072 + 1024 + h * 64 + sub * 16;
    u32x4 v0 = *(const u32x4*)vs, v1 = *(const u32x4*)(vs + 8);
#pragma unroll
    for (int e = 0; e < 4; ++e) {
      VT[(sub * 16 + e * 2) * 72 + tok] = (u16)(v0[e] & 0xffffu); VT[(sub * 16 + e * 2 + 1) * 72 + tok] = (u16)(v0[e] >> 16);
      VT[(sub * 16 + 8 + e * 2) * 72 + tok] = (u16)(v1[e] & 0xffffu); VT[(sub * 16 + 8 + e * 2 + 1) * 72 + tok] = (u16)(v1[e] >> 16);
    }
  }
  __syncthreads();
  {
    const int lane = tid & 63, w = tid >> 6, r = lane & 15, g = lane >> 4;
    const int dir = w >> 1, dt = w & 1;
    float* UPD = (float*)(p.ws + WS_GUPD) + (size_t)((tt * 2 + dir) * 4 + h) * 2048;
    bf16x8 b0 = ldfrag(KoutT + (dir * 32 + dt * 16 + r) * 72 + g * 8), b1 = ldfrag(KoutT + (dir * 32 + dt * 16 + r) * 72 + 32 + g * 8);
#pragma unroll
    for (int et = 0; et < 4; ++et) {
      f32x4 acc = (f32x4){0.f, 0.f, 0.f, 0.f};
      acc = mfma(ldfrag(VT + (et * 16 + r) * 72 + g * 8), b0, acc);
      acc = mfma(ldfrag(VT + (et * 16 + r) * 72 + 32 + g * 8), b1, acc);
      *(float4*)(UPD + (dt * 16 + r) * 64 + et * 16 + g * 4) = make_float4(acc[0], acc[1], acc[2], acc[3]);
    }
    if (tid < 64) ((float*)(p.ws + WS_GDEC))[((tt * 2 + (tid >> 5)) * 4 + h) * 32 + (tid & 31)] = __expf(TT[tid]);
  }
  __syncthreads();
}

DI float softplus(float x) { return x > 20.f ? x : log1pf(__expf(x)); }

DI void c_ssd(const P& p, int l, int tt, int grp, char* smem) {
  const TI ti = tile_info(tt);
  const int t0 = ti.t0;
  u16* XsT = (u16*)smem;
  u16* BwT = XsT + 128 * 72;
  float* DT = (float*)(BwT + 4 * 64 * 72);
  float* CUM = DT + 256; float* WJ = CUM + 256; float* TOT = WJ + 256;
  const u16* U = (const u16*)(p.ws + WS_U);
  const float* SIDE = (const float*)(p.ws + WS_SIDE);
  u16* XBC = (u16*)(p.ws + WS_XBC);
  const int tid = otid();
  {
    const int tok = tid & 63, combo = tid >> 6, dir = combo >> 1, head = grp * 2 + (combo & 1);
    const float raw = SIDE[(size_t)(t0 + tok) * 40 + 32 + dir * 4 + head] + p.in[27][(l * 2 + dir) * 4 + head];
    const float dt = softplus(raw);
    DT[tid] = dt; CUM[tid] = -__expf(p.in[28][(l * 2 + dir) * 4 + head]) * dt;
  }
  __syncthreads();
  {
    const int lane = tid & 63, w = tid >> 6, dir = w >> 1;
    const int j = dir ? 63 - lane : lane;
    float v = CUM[w * 64 + j];
    v = wave_incl_scan(v, lane);
    CUM[w * 64 + j] = v;
    if (lane == 63) TOT[w] = v;
  }
  __syncthreads();
  WJ[tid] = DT[tid] * __expf(TOT[tid >> 6] - CUM[tid]);
  __syncthreads();
  {
    const int co = tid & 31, tg = tid >> 5;
    int ch;
    if (co < 16) ch = grp * 128 + co * 8; else if (co < 24) ch = 256 + grp * 64 + (co - 16) * 8; else ch = 384 + grp * 64 + (co - 24) * 8;
    const int jb = tg * 8;
    u32x4 xr[12];
#pragma unroll
    for (int w = 0; w < 12; ++w) {
      const int n = ti.n0 + jb + w - 2;
      xr[w] = (n >= 0 && n < ti.N) ? *(const u32x4*)(U + (size_t)(t0 + jb + w - 2) * 3072 + 2432 + ch) : (u32x4){0u, 0u, 0u, 0u};
    }
    float cw[5][8], cb[8];
#pragma unroll
    for (int w = 0; w < 5; ++w) {
      const float4 c0 = *(const float4*)(p.in[25] + (size_t)(l * 5 + w) * 512 + ch), c1 = *(const float4*)(p.in[25] + (size_t)(l * 5 + w) * 512 + ch + 4);
      cw[w][0] = c0.x; cw[w][1] = c0.y; cw[w][2] = c0.z; cw[w][3] = c0.w; cw[w][4] = c1.x; cw[w][5] = c1.y; cw[w][6] = c1.z; cw[w][7] = c1.w;
    }
    {
      const float4 c0 = *(const float4*)(p.in[26] + l * 512 + ch), c1 = *(const float4*)(p.in[26] + l * 512 + ch + 4);
      cb[0] = c0.x; cb[1] = c0.y; cb[2] = c0.z; cb[3] = c0.w; cb[4] = c1.x; cb[5] = c1.y; cb[6] = c1.z; cb[7] = c1.w;
    }
#pragma unroll
    for (int jj = 0; jj < 8; ++jj) {
      const int j = jb + jj;
      float a[8];
#pragma unroll
      for (int e = 0; e < 8; ++e) a[e] = cb[e];
#pragma unroll
      for (int w = 0; w < 5; ++w)
#pragma unroll
        for (int e = 0; e < 4; ++e) { a[2 * e] += lo2f(xr[jj + w][e]) * cw[w][2 * e]; a[2 * e + 1] += hi2f(xr[jj + w][e]) * cw[w][2 * e + 1]; }
#pragma unroll
      for (int e = 0; e < 8; ++e) a[e] = silu(a[e]);
      u32x4 o; o[0] = pack2(a[0], a[1]); o[1] = pack2(a[2], a[3]); o[2] = pack2(a[4], a[5]); o[3] = pack2(a[6], a[7]);
      *(u32x4*)(XBC + (size_t)(t0 + j) * 512 + ch) = o;
      if (co < 16) {
#pragma unroll
        for (int e = 0; e < 8; ++e) XsT[(co * 8 + e) * 72 + j] = f2bf(a[e]);
      } else if (co < 24) {
        const int s2 = (co - 16) * 8;
#pragma unroll
        for (int cb4 = 0; cb4 < 4; ++cb4) {
          const float wj = WJ[cb4 * 64 + j];
#pragma unroll
          for (int e = 0; e < 8; ++e) BwT[(cb4 * 64 + s2 + e) * 72 + j] = f2bf(a[e] * wj);
        }
      }
    }
  }
  __syncthreads();
  {
    const int lane = tid & 63, w = tid >> 6, r = lane & 15, g = lane >> 4;
    const int dir = w >> 1, hd = w & 1, head = grp * 2 + hd;
    float* ST = (float*)(p.ws + WS_SST) + (size_t)((tt * 2 + dir) * 4 + head) * 4096;
    for (int pt = 0; pt < 4; ++pt) {
      bf16x8 b0 = ldfrag(XsT + (hd * 64 + pt * 16 + r) * 72 + g * 8), b1 = ldfrag(XsT + (hd * 64 + pt * 16 + r) * 72 + 32 + g * 8);
#pragma unroll
      for (int st = 0; st < 4; ++st) {
        f32x4 acc = (f32x4){0.f, 0.f, 0.f, 0.f};
        acc = mfma(ldfrag(BwT + (w * 64 + st * 16 + r) * 72 + g * 8), b0, acc);
        acc = mfma(ldfrag(BwT + (w * 64 + st * 16 + r) * 72 + 32 + g * 8), b1, acc);
        *(float4*)(ST + (pt * 16 + r) * 64 + st * 16 + g * 4) = make_float4(acc[0], acc[1], acc[2], acc[3]);
      }
    }
    if (tid < 4) ((float*)(p.ws + WS_SDEC))[(tt * 2 + (tid >> 1)) * 4 + grp * 2 + (tid & 1)] = __expf(TOT[tid]);
  }
  __syncthreads();
}

template <int KS>
DI void attn_block(const u16* __restrict__ Q, int qstride, const u16* __restrict__ K, int kstride, const u16* __restrict__ VT, int nk,
                   const u16* __restrict__ gate, u16* ocat, int tokb, char* smem) {
  constexpr int KLD = KS == 2 ? 64 : 128;
  constexpr int BUF = 64 * KLD + 64 * 64;
  constexpr int KCH = KS * 4;
  u16* sm = (u16*)smem;
  const int tid = otid(), lane = tid & 63, w = tid >> 6, r = lane & 15, g = lane >> 4;
  const int tok0 = tokb + w * 32;
  bf16x8 qf[2][KS];
#pragma unroll
  for (int q = 0; q < 2; ++q)
#pragma unroll
    for (int s = 0; s < KS; ++s) qf[q][s] = ldfrag(Q + (size_t)(tok0 + q * 16 + r) * qstride + s * 32 + g * 8);
  f32x4 o[2][4];
#pragma unroll
  for (int q = 0; q < 2; ++q)
#pragma unroll
    for (int e = 0; e < 4; ++e) o[q][e] = (f32x4){0.f, 0.f, 0.f, 0.f};
  float m[2] = {-1e30f, -1e30f}, lsum[2] = {0.f, 0.f};
  u32x4 rk0[KS], rv0[2], rk1[KS], rv1[2];
  int koff[KS], voff[2];
#pragma unroll
  for (int i = 0; i < KS; ++i) {
    const int id = tid + 256 * i, row = id / KCH, ch = id % KCH;
    const int f = KS == 2 ? (((row >> 1) & 1) | (((row >> 3) & 3) << 1)) : ((row & 3) | (((row >> 3) & 3) << 2));
    koff[i] = row * KLD + ((ch ^ f) * 8);
  }
#pragma unroll
  for (int i = 0; i < 2; ++i) { const int id = tid + 256 * i, row = id >> 3, ch = id & 7; voff[i] = 64 * KLD + row * 64 + ((ch ^ ((row >> 1) & 7)) * 8); }
  const int nit = nk >> 6;
  const int qtile = (tokb >> 7) & 15;
  const int start = (qtile * nit) >> 4;
  auto gload = [&](u32x4* rk, u32x4* rv, int it) {
    int tix = it + start; if (tix >= nit) tix -= nit;
    const int k0 = tix * 64;
#pragma unroll
    for (int i = 0; i < KS; ++i) { const int id = tid + 256 * i; rk[i] = *(const u32x4*)(K + (size_t)(k0 + id / KCH) * kstride + (id % KCH) * 8); }
#pragma unroll
    for (int i = 0; i < 2; ++i) { const int id = tid + 256 * i; rv[i] = *(const u32x4*)(VT + (size_t)(id >> 3) * nk + k0 + (id & 7) * 8); }
  };
  auto lstore = [&](const u32x4* rk, const u32x4* rv, int bufi) {
    u16* nb = sm + bufi * BUF;
#pragma unroll
    for (int i = 0; i < KS; ++i) *(u32x4*)(nb + koff[i]) = rk[i];
#pragma unroll
    for (int i = 0; i < 2; ++i) *(u32x4*)(nb + voff[i]) = rv[i];
  };
  const int krow0 = (r >> 2) * 8 + (r & 3);
  const int fk = KS == 2 ? (((krow0 >> 1) & 1) | (((krow0 >> 3) & 3) << 1)) : ((krow0 & 3) | (((krow0 >> 3) & 3) << 2));
  const int fv = (r >> 1) & 7;
  auto compute = [&](int bufi) {
    const u16* kb = sm + bufi * BUF; const u16* vb = kb + 64 * KLD;
    f32x4 sc[2][2][2];
#pragma unroll
    for (int sb = 0; sb < 2; ++sb) {
      const int krow = sb * 32 + krow0;
#pragma unroll
      for (int q = 0; q < 2; ++q) { sc[q][sb][0] = (f32x4){0.f, 0.f, 0.f, 0.f}; sc[q][sb][1] = sc[q][sb][0]; }
#pragma unroll
      for (int s = 0; s < KS; ++s) {
        const int co = ((s * 4 + g) ^ fk) * 8;
        const bf16x8 k0f = ldfrag(kb + krow * KLD + co), k1f = ldfrag(kb + (krow + 4) * KLD + co);
#pragma unroll
        for (int q = 0; q < 2; ++q) { sc[q][sb][0] = mfma(k0f, qf[q][s], sc[q][sb][0]); sc[q][sb][1] = mfma(k1f, qf[q][s], sc[q][sb][1]); }
      }
    }
    bf16x8 pf[2][2];
#pragma unroll
    for (int q = 0; q < 2; ++q) {
      float mx = fmaxf(fmaxf(fmaxf(sc[q][0][0][0], sc[q][0][0][1]), fmaxf(sc[q][0][0][2], sc[q][0][0][3])), fmaxf(fmaxf(sc[q][0][1][0], sc[q][0][1][1]), fmaxf(sc[q][0][1][2], sc[q][0][1][3])));
      const float mx1 = fmaxf(fmaxf(fmaxf(sc[q][1][0][0], sc[q][1][0][1]), fmaxf(sc[q][1][0][2], sc[q][1][0][3])), fmaxf(fmaxf(sc[q][1][1][0], sc[q][1][1][1]), fmaxf(sc[q][1][1][2], sc[q][1][1][3])));
      mx = fmaxf(mx, mx1);
      mx = xmax16(mx); mx = xmax32(mx);
      if (__any(mx > m[q])) {
        const float mnew = fmaxf(m[q], mx);
        const float alpha = __builtin_amdgcn_exp2f(m[q] - mnew);
        m[q] = mnew;
        lsum[q] *= alpha;
#pragma unroll
        for (int e = 0; e < 4; ++e) o[q][e] = o[q][e] * alpha;
      }
#pragma unroll
      for (int sb = 0; sb < 2; ++sb) {
        float pp[8];
#pragma unroll
        for (int i = 0; i < 4; ++i) { pp[i] = __builtin_amdgcn_exp2f(sc[q][sb][0][i] - m[q]); pp[4 + i] = __builtin_amdgcn_exp2f(sc[q][sb][1][i] - m[q]); }
        lsum[q] += ((pp[0] + pp[1]) + (pp[2] + pp[3])) + ((pp[4] + pp[5]) + (pp[6] + pp[7]));
        u32x4 pk; pk[0] = pack2(pp[0], pp[1]); pk[1] = pack2(pp[2], pp[3]); pk[2] = pack2(pp[4], pp[5]); pk[3] = pack2(pp[6], pp[7]);
        pf[q][sb] = __builtin_bit_cast(bf16x8, pk);
      }
    }
#pragma unroll
    for (int sb = 0; sb < 2; ++sb) {
      const int vo = ((sb * 4 + g) ^ fv) * 8;
#pragma unroll
      for (int e = 0; e < 4; ++e) {
        const bf16x8 vf = ldfrag(vb + (e * 16 + r) * 64 + vo);
        o[0][e] = mfma(vf, pf[0][sb], o[0][e]);
        o[1][e] = mfma(vf, pf[1][sb], o[1][e]);
      }
    }
  };
  gload(rk0, rv0, 0);
  gload(rk1, rv1, 1);
  lstore(rk0, rv0, 0);
  __syncthreads();
  for (int it = 0; it < nit; it += 2) {
    if (it + 2 < nit) gload(rk0, rv0, it + 2);
    compute(0);
    lstore(rk1, rv1, 1);
    __syncthreads();
    if (it + 3 < nit) gload(rk1, rv1, it + 3);
    compute(1);
    if (it + 2 < nit) lstore(rk0, rv0, 0);
    __syncthreads();
  }
#pragma unroll
  for (int q = 0; q < 2; ++q) {
    float lt = lsum[q];
    lt = xsum16(lt); lt = xsum32(lt);
    const float inv = 1.f / lt;
    const int tok = tok0 + q * 16 + r;
#pragma unroll
    for (int e = 0; e < 4; ++e) {
      const int dv = e * 16 + g * 4;
      float gt[4]; ld4bf(gate + (size_t)tok * 3072 + dv, gt);
      st4bf(ocat + (size_t)tok * 1024 + dv, o[q][e][0] * inv * silu(gt[0]), o[q][e][1] * inv * silu(gt[1]), o[q][e][2] * inv * silu(gt[2]), o[q][e][3] * inv * silu(gt[3]));
    }
  }
}

DI void d_attn(const P& p, int kind, int seqtok0, int kvoff, int nk, int h, int qt, char* smem) {
  const u16* U = (const u16*)(p.ws + WS_U); u16* Ocat = (u16*)(p.ws + WS_H);
  const int tokb = seqtok0 + qt * 128;
  if (kind == 0) {
    const u16* Qg = (const u16*)(p.ws + WS_QG); const u16* Kg = (const u16*)(p.ws + WS_KG); const u16* VgT = (const u16*)(p.ws + WS_VGT);
    attn_block<2>(Qg + h * 64, 256, Kg + (size_t)kvoff * 128 + (h >> 1) * 64, 128, VgT + (size_t)kvoff * 128 + (size_t)(h >> 1) * 64 * nk, nk, U + 512 + h * 64, Ocat + h * 64, tokb, smem);
  } else {
    const u16* Qm = (const u16*)(p.ws + WS_QM); const u16* Km = (const u16*)(p.ws + WS_KM); const u16* VmT = (const u16*)(p.ws + WS_VMT);
    attn_block<3>(Qm + h * 96, 384, Km + (size_t)kvoff * 384 + h * 96, 384, VmT + (size_t)kvoff * 256 + (size_t)h * 64 * nk, nk, U + 1920 + h * 64, Ocat + 512 + h * 64, tokb, smem);
  }
}

DI void d_gla(const P& p, int l, int tt, int h, char* smem) {
  const TI ti = tile_info(tt);
  const int t0 = ti.t0;
  float* CB = (float*)smem; float* TT = CB + 4096;
  u16* ATT = (u16*)smem;
  u16* Qd = (u16*)(TT + 64);
  u16* Kin = Qd + 2 * 64 * 40;
  u16* VT = Kin + 2 * 64 * 40;
  u16* ST = VT + 64 * 72;
  const u16* U = (const u16*)(p.ws + WS_U);
  const int tid = otid();
  {
    const float* src = (const float*)(p.ws + WS_CBG) + (size_t)(tt * 4 + h) * 4160;
#pragma unroll
    for (int i = 0; i < 4; ++i) *(float4*)(CB + (tid + 256 * i) * 4) = *(const float4*)(src + (tid + 256 * i) * 4);
    if (tid < 16) *(float4*)(TT + tid * 4) = *(const float4*)(src + 4096 + tid * 4);
  }
  __syncthreads();
  {
    const int tok = tid >> 2, sub = tid & 3;
    float q[8], k[8];
    ld8bf(U + (size_t)(t0 + tok) * 3072 + 768 + h * 32 + sub * 8, q);
    ld8bf(U + (size_t)(t0 + tok) * 3072 + 896 + h * 32 + sub * 8, k);
#pragma unroll
    for (int dir = 0; dir < 2; ++dir) {
      float qd[8], ki[8];
#pragma unroll
      for (int e = 0; e < 8; ++e) { const float cb = CB[(dir * 64 + tok) * 32 + sub * 8 + e]; qd[e] = q[e] * 0.17677669529f * __expf(cb); ki[e] = k[e] * __expf(-cb); }
      st4bf(Qd + (dir * 64 + tok) * 40 + sub * 8, qd[0], qd[1], qd[2], qd[3]); st4bf(Qd + (dir * 64 + tok) * 40 + sub * 8 + 4, qd[4], qd[5], qd[6], qd[7]);
      st4bf(Kin + (dir * 64 + tok) * 40 + sub * 8, ki[0], ki[1], ki[2], ki[3]); st4bf(Kin + (dir * 64 + tok) * 40 + sub * 8 + 4, ki[4], ki[5], ki[6], ki[7]);
    }
    const u16* vs = U + (size_t)(t0 + tok) * 3072 + 1024 + h * 64 + sub * 16;
    u32x4 v0 = *(const u32x4*)vs, v1 = *(const u32x4*)(vs + 8);
#pragma unroll
    for (int e = 0; e < 4; ++e) {
      VT[(sub * 16 + e * 2) * 72 + tok] = (u16)(v0[e] & 0xffffu); VT[(sub * 16 + e * 2 + 1) * 72 + tok] = (u16)(v0[e] >> 16);
      VT[(sub * 16 + 8 + e * 2) * 72 + tok] = (u16)(v1[e] & 0xffffu); VT[(sub * 16 + 8 + e * 2 + 1) * 72 + tok] = (u16)(v1[e] >> 16);
    }
  }
  {
    const int d = tid >> 3, e0 = (tid & 7) * 8;
    const float* GUPD = (const float*)(p.ws + WS_GUPD);
#pragma unroll
    for (int dir = 0; dir < 2; ++dir) {
      const float* up = GUPD + (size_t)((tt * 2 + dir) * 4 + h) * 2048 + tid * 8;
      const float4 a = *(const float4*)up, b4 = *(const float4*)(up + 4);
      const float S[8] = {a.x, a.y, a.z, a.w, b4.x, b4.y, b4.z, b4.w};
#pragma unroll
      for (int e = 0; e < 8; ++e) ST[(dir * 64 + e0 + e) * 40 + d] = f2bf(S[e]);
    }
  }
  __syncthreads();
  const int lane = tid & 63, w = tid >> 6, r = lane & 15, g = lane >> 4;
  f32x4 o[4];
#pragma unroll
  for (int e = 0; e < 4; ++e) o[e] = (f32x4){0.f, 0.f, 0.f, 0.f};
  for (int dir = 0; dir < 2; ++dir) {
    const bf16x8 bq = ldfrag(Qd + (dir * 64 + w * 16 + r) * 40 + g * 8);
    const int itok = w * 16 + r;
#pragma unroll
    for (int jt = 0; jt < 4; ++jt) {
      f32x4 s = mfma(ldfrag(Kin + (dir * 64 + jt * 16 + r) * 40 + g * 8), bq, (f32x4){0.f, 0.f, 0.f, 0.f});
      float v[4];
#pragma unroll
      for (int i = 0; i < 4; ++i) { const int j = jt * 16 + g * 4 + i; const bool keep = dir == 0 ? (j <= itok) : (j >= itok); v[i] = keep ? s[i] : 0.f; }
      st4bf(ATT + itok * 72 + jt * 16 + g * 4, v[0], v[1], v[2], v[3]);
    }
    __syncthreads();
#pragma unroll
    for (int s = 0; s < 2; ++s) {
      const bf16x8 bt = ldfrag(ATT + (w * 16 + r) * 72 + s * 32 + g * 8);
#pragma unroll
      for (int et = 0; et < 4; ++et) o[et] = mfma(ldfrag(VT + (et * 16 + r) * 72 + s * 32 + g * 8), bt, o[et]);
    }
#pragma unroll
    for (int et = 0; et < 4; ++et) o[et] = mfma(ldfrag(ST + (dir * 64 + et * 16 + r) * 40 + g * 8), bq, o[et]);
    __syncthreads();
  }
  float ss = 0;
#pragma unroll
  for (int et = 0; et < 4; ++et) ss += o[et][0] * o[et][0] + o[et][1] * o[et][1] + o[et][2] * o[et][2] + o[et][3] * o[et][3];
  ss = xsum16(ss); ss = xsum32(ss);
  const float rr = rsqrtf(ss * (1.f / 64.f) + EPS);
  const int t = t0 + w * 16 + r;
  u16* Ocat = (u16*)(p.ws + WS_H);
#pragma unroll
  for (int et = 0; et < 4; ++et) {
    const int e = et * 16 + g * 4;
    float gt[4]; ld4bf(U + (size_t)t * 3072 + 1312 + h * 64 + e, gt);
    const float4 gn = *(const float4*)(p.in[20] + l * 64 + e);
    st4bf(Ocat + (size_t)t * 1024 + 256 + h * 64 + e, o[et][0] * rr * gn.x * silu(gt[0]), o[et][1] * rr * gn.y * silu(gt[1]), o[et][2] * rr * gn.z * silu(gt[2]), o[et][3] * rr * gn.w * silu(gt[3]));
  }
  __syncthreads();
}

DI void d_ssd(const P& p, int l, int tt, int grp, char* smem) {
  const TI ti = tile_info(tt);
  const int t0 = ti.t0;
  u16* XsT = (u16*)smem;
  u16* Bm = XsT + 128 * 72;
  u16* Cm = Bm + 64 * 72;
  u16* M = Cm + 64 * 72;
  u16* Hst = M + 64 * 72;
  float* DT = (float*)(Hst + 64 * 72);
  float* CUM = DT + 512; float* TOT = CUM + 512;
  const u16* U = (const u16*)(p.ws + WS_U);
  const float* SIDE = (const float*)(p.ws + WS_SIDE);
  const u16* XBC = (const u16*)(p.ws + WS_XBC);
  const float* SST = (const float*)(p.ws + WS_SST);
  const int tid = otid(), lane = tid & 63, w = tid >> 6, r = lane & 15, g = lane >> 4;
  {
    const int tok = tid & 63, head = tid >> 6;
#pragma unroll
    for (int dir = 0; dir < 2; ++dir) {
      const float raw = SIDE[(size_t)(t0 + tok) * 40 + 32 + dir * 4 + head] + p.in[27][(l * 2 + dir) * 4 + head];
      const float dt = softplus(raw);
      DT[(dir * 4 + head) * 64 + tok] = dt; CUM[(dir * 4 + head) * 64 + tok] = -__expf(p.in[28][(l * 2 + dir) * 4 + head]) * dt;
    }
  }
  __syncthreads();
  {
#pragma unroll
    for (int dir = 0; dir < 2; ++dir) {
      const int cb8 = dir * 4 + w;
      const int j = dir ? 63 - lane : lane;
      float v = CUM[cb8 * 64 + j];
      v = wave_incl_scan(v, lane);
      CUM[cb8 * 64 + j] = v;
      if (lane == 63) TOT[cb8] = v;
    }
  }
  float ss = 0;
  const int itok = w * 16 + r;
  const int t = t0 + itok;
  {
    f32x4 y[2][4];
#pragma unroll
    for (int a = 0; a < 2; ++a)
#pragma unroll
      for (int b = 0; b < 4; ++b) y[a][b] = (f32x4){0.f, 0.f, 0.f, 0.f};
    __syncthreads();
    {
      const int tok = tid >> 2, sub = tid & 3;
      const u16* xs = XBC + (size_t)(t0 + tok) * 512 + grp * 128 + sub * 32;
#pragma unroll
      for (int q = 0; q < 4; ++q) {
        u32x4 v = *(const u32x4*)(xs + q * 8);
#pragma unroll
        for (int e = 0; e < 4; ++e) { XsT[(sub * 32 + q * 8 + e * 2) * 72 + tok] = (u16)(v[e] & 0xffffu); XsT[(sub * 32 + q * 8 + e * 2 + 1) * 72 + tok] = (u16)(v[e] >> 16); }
      }
      const u16* bs = XBC + (size_t)(t0 + tok) * 512 + 256 + grp * 64 + sub * 16;
      *(u32x4*)(Bm + tok * 72 + sub * 16) = *(const u32x4*)bs; *(u32x4*)(Bm + tok * 72 + sub * 16 + 8) = *(const u32x4*)(bs + 8);
      const u16* cs = XBC + (size_t)(t0 + tok) * 512 + 384 + grp * 64 + sub * 16;
      *(u32x4*)(Cm + tok * 72 + sub * 16) = *(const u32x4*)cs; *(u32x4*)(Cm + tok * 72 + sub * 16 + 8) = *(const u32x4*)(cs + 8);
    }
    __syncthreads();
    f32x4 sc[4];
    const bf16x8 c0 = ldfrag(Cm + (w * 16 + r) * 72 + g * 8), c1 = ldfrag(Cm + (w * 16 + r) * 72 + 32 + g * 8);
#pragma unroll
    for (int jt = 0; jt < 4; ++jt) {
      sc[jt] = mfma(ldfrag(Bm + (jt * 16 + r) * 72 + g * 8), c0, (f32x4){0.f, 0.f, 0.f, 0.f});
      sc[jt] = mfma(ldfrag(Bm + (jt * 16 + r) * 72 + 32 + g * 8), c1, sc[jt]);
    }
#pragma unroll
    for (int hd = 0; hd < 2; ++hd) {
      const int head = grp * 2 + hd;
      for (int dir = 0; dir < 2; ++dir) {
        const int cb8 = dir * 4 + head;
        const float ci = CUM[cb8 * 64 + itok];
#pragma unroll
        for (int jt = 0; jt < 4; ++jt) {
          float v[4];
#pragma unroll
          for (int i = 0; i < 4; ++i) {
            const int j = jt * 16 + g * 4 + i; const bool keep = dir == 0 ? (j <= itok) : (j >= itok);
            v[i] = keep ? sc[jt][i] * __expf(ci - CUM[cb8 * 64 + j]) * DT[cb8 * 64 + j] : 0.f;
          }
          st4bf(M + itok * 72 + jt * 16 + g * 4, v[0], v[1], v[2], v[3]);
        }
        {
          const int pp = tid >> 2, s0 = (tid & 3) * 16;
          const float* st = SST + (size_t)((tt * 2 + dir) * 4 + head) * 4096 + tid * 16;
          const float4 h0 = ((const float4*)st)[0], h1 = ((const float4*)st)[1], h2 = ((const float4*)st)[2], h3 = ((const float4*)st)[3];
          st4bf(Hst + pp * 72 + s0, h0.x, h0.y, h0.z, h0.w); st4bf(Hst + pp * 72 + s0 + 4, h1.x, h1.y, h1.z, h1.w);
          st4bf(Hst + pp * 72 + s0 + 8, h2.x, h2.y, h2.z, h2.w); st4bf(Hst + pp * 72 + s0 + 12, h3.x, h3.y, h3.z, h3.w);
        }
        __syncthreads();
        const float ei = __expf(ci);
        const bf16x8 m0 = ldfrag(M + (w * 16 + r) * 72 + g * 8), m1 = ldfrag(M + (w * 16 + r) * 72 + 32 + g * 8);
#pragma unroll
        for (int pt = 0; pt < 4; ++pt) {
          y[hd][pt] = mfma(ldfrag(XsT + (hd * 64 + pt * 16 + r) * 72 + g * 8), m0, y[hd][pt]);
          y[hd][pt] = mfma(ldfrag(XsT + (hd * 64 + pt * 16 + r) * 72 + 32 + g * 8), m1, y[hd][pt]);
          f32x4 tmp = mfma(ldfrag(Hst + (pt * 16 + r) * 72 + g * 8), c0, (f32x4){0.f, 0.f, 0.f, 0.f});
          tmp = mfma(ldfrag(Hst + (pt * 16 + r) * 72 + 32 + g * 8), c1, tmp);
          y[hd][pt] = y[hd][pt] + tmp * ei;
        }
        __syncthreads();
      }
      const float dsk = p.in[29][l * 4 + head];
#pragma unroll
      for (int pt = 0; pt < 4; ++pt) {
        float z[4]; ld4bf(U + (size_t)t * 3072 + 2176 + head * 64 + pt * 16 + g * 4, z);
        float v[4];
#pragma unroll
        for (int i = 0; i < 4; ++i) {
          v[i] = (y[hd][pt][i] + dsk * bf2f(XsT[(hd * 64 + pt * 16 + g * 4 + i) * 72 + itok])) * silu(z[i]);
          ss += v[i] * v[i];
        }
        const int c = head * 64 + pt * 16 + g * 4;
        const float4 gn = *(const float4*)(p.in[30] + l * 256 + c);
        st4bf((u16*)(p.ws + WS_H) + (size_t)t * 1024 + 768 + c, v[0] * gn.x, v[1] * gn.y, v[2] * gn.z, v[3] * gn.w);
      }
    }
  }
  ss = xsum16(ss); ss = xsum32(ss);
  if (g == 0) ((float*)(p.ws + WS_SSQ))[t * 2 + grp] = ss;
  __syncthreads();
}


DI void phaseS(const P& p, int l) {
  const int tid = otid();
  float* GUPD = (float*)(p.ws + WS_GUPD); const float* GDEC = (const float*)(p.ws + WS_GDEC);
  float* SST = (float*)(p.ws + WS_SST); const float* SDEC = (const float*)(p.ws + WS_SDEC);
  const int total = 34 * 8 * 1536;
  for (int idx = blockIdx.x * 256 + tid; idx < total; idx += gridDim.x * 256) {
    const int e = idx % 1536; const int rest = idx / 1536; const int head = rest & 3, dir = (rest >> 2) & 1, seq = rest >> 3;
    int nc, tt0, isctx, b;
    if (seq < 32) { nc = 4; tt0 = seq * 4; isctx = 1; b = seq; } else { nc = 32; tt0 = 128 + (seq - 32) * 32; isctx = 0; b = seq - 32; }
    const bool gla = e < 512;
    const int e4 = gla ? e * 4 : (e - 512) * 4;
    const int esz = gla ? 2048 : 4096;
    float* base = gla ? GUPD : SST;
    const float* s0p = (gla ? p.in[7] : p.in[8]) + (size_t)(((b * 2 + l) * 2 + dir) * 4 + head) * esz + e4;
    float4 S = isctx ? make_float4(0.f, 0.f, 0.f, 0.f) : *(const float4*)s0p;
    for (int q0 = 0; q0 < nc; q0 += 4) {
      float4 u[4]; float dec[4]; float4* up[4];
#pragma unroll
      for (int k = 0; k < 4; ++k) {
        const int cc = dir == 0 ? q0 + k : nc - 1 - (q0 + k);
        const int chunk = tt0 + cc;
        up[k] = (float4*)(base + (size_t)((chunk * 2 + dir) * 4 + head) * esz + e4);
        u[k] = *up[k];
        dec[k] = gla ? GDEC[((chunk * 2 + dir) * 4 + head) * 32 + (e4 >> 6)] : SDEC[(chunk * 2 + dir) * 4 + head];
      }
#pragma unroll
      for (int k = 0; k < 4; ++k) {
        *up[k] = S;
        S.x = dec[k] * S.x + u[k].x; S.y = dec[k] * S.y + u[k].y; S.z = dec[k] * S.z + u[k].z; S.w = dec[k] * S.w + u[k].w;
      }
    }
    if (isctx) *(float4*)(p.out + (gla ? OUT_SG : OUT_SS) + (size_t)(((b * 2 + l) * 2 + dir) * 4 + head) * esz + e4) = S;
  }
}

DI void phaseB(const P& p, int l, char* smem) {
  const int xcd = blockIdx.x & 7, slot = blockIdx.x >> 3, nslot = gridDim.x >> 3;
  for (int i = slot; i < 288; i += nslot) {
    const int ntb = i / 96, rem = i % 96;
    gemm_tile<0>((const u16*)(p.ws + WS_H), (const u16*)(p.ws + WS_WINT) + (size_t)l * 3072 * 1024, xcd * 12 + (rem >> 3), ntb * 8 + (rem & 7), p.ws + WS_U, (float*)(p.ws + WS_SIDE), smem);
  }
}
DI void phaseE(const P& p, int l, char* smem) {
  const int xcd = blockIdx.x & 7, slot = blockIdx.x >> 3, nslot = gridDim.x >> 3;
  for (int i = slot; i < 128; i += nslot)
    gemm_tile<1>((const u16*)(p.ws + WS_H), (const u16*)(p.ws + WS_WOUTT) + (size_t)l * 1024 * 1024, xcd * 16 + (i >> 3), i & 7, p.ws + WS_U, (float*)(p.ws + WS_SSQ), smem);
}
DI void phaseC(const P& p, int l, char* smem) {
  for (int job = blockIdx.x; job < 1744; job += gridDim.x) {
    if (job < 384) c_ssd(p, l, job >> 1, job & 1, smem);
    else if (job >= 400 && job < 416) c_cache(p, l, job - 400, smem);
    else if (job < 1360) { const int idx = job < 400 ? job - 384 : job - 400; if (idx < 768) c_gla(p, l, idx >> 2, idx & 3, smem); else c_gqa(p, l, idx - 768, smem); }
    else { const int idx = job - 1360; if (idx < 192) c_mla_q(p, l, idx, smem); else c_mla_kv(p, l, idx - 192, smem); }
  }
}
DI void d_light(const P& p, int l, int j, char* smem) {
  if (j < 384) d_ssd(p, l, j >> 1, j & 1, smem);
  else if (j < 1152) { const int q = j - 384; d_gla(p, l, q >> 2, q & 3, smem); }
  else {
    const int q = j - 1152; const int kind = q >> 8, rem = q & 255; const int seq = rem >> 3, h = (rem >> 1) & 3, qt = rem & 1;
    d_attn(p, kind, seq * 256, seq * 256, 256, h, qt, smem);
  }
}
DI void phaseD(const P& p, int l, char* smem) {
  const int bid = blockIdx.x, G = gridDim.x;
  for (int step = 0;; ++step) {
    int heavy = -1, light = -1;
    if (G == 512) {
      if (step > 4) break;
      if (bid < 256) { if (step == 0) heavy = bid; else if (step == 1) light = 1152 + bid; else if (step == 2) light = 896 + bid; }
      else {
        const int nb = bid - 256;
        if (nb < 128) { if (step < 4) light = step * 128 + nb; }
        else if (step < 3) light = 384 + step * 128 + nb;
        else light = 1408 + (nb - 128) * 2 + (step - 3);
      }
    } else {
      const int job = bid + step * G;
      if (job >= 256 + 1664) break;
      if (job < 256) heavy = job; else light = job - 256;
    }
    if (heavy >= 0) {
      const int combo = (heavy & 7) * 2 + (heavy >> 7), qt = (heavy >> 3) & 15;
      const int kind = combo >> 3, b = (combo >> 2) & 1, h = combo & 3;
      d_attn(p, kind, 8192 + b * 2048, 8192 + b * 2560, 2560, h, qt, smem);
    } else if (light >= 0) d_light(p, l, light, smem);
  }
}

__global__ void __launch_bounds__(256, 2) mega(P p) {
  __shared__ __attribute__((aligned(16))) char smem[SMEM_BYTES];
  __shared__ uint4 xb_words;
  if (threadIdx.x == 0) xb_words = make_uint4(0u, 0u, 0u, 0u);
  __syncthreads();
  const XcdBarrier xb = xcd_barrier_post((unsigned*)(p.ws + WS_BAR), (volatile LAS unsigned*)&xb_words);
  if (p.out == nullptr) cg::this_grid().sync();
  phase0(p, smem);
  xcd_barrier(xb);
  for (int l = 0; l < 2; ++l) {
    phaseA(p, l); xcd_barrier(xb);
    phaseB(p, l, smem); xcd_barrier(xb);
    phaseC(p, l, smem); xcd_barrier(xb);
    phaseS(p, l); xcd_barrier(xb);
    phaseD(p, l, smem); xcd_barrier(xb);
    phaseE(p, l, smem); xcd_barrier(xb);
  }
  phaseA(p, 2);
}

extern "C" void kernel_launch(void* const* d_in, const int* in_sizes, int n_in, void* d_out, int out_size, void* d_ws, size_t ws_size, hipStream_t stream) {
  static int grid_blocks = 0;
  if (!grid_blocks) {
    int dev = 0, cus = 0, per_cu = 0;
    hipGetDevice(&dev);
    hipDeviceGetAttribute(&cus, hipDeviceAttributeMultiprocessorCount, dev);
    hipOccupancyMaxActiveBlocksPerMultiprocessor(&per_cu, mega, 256, 0);
    if (per_cu > 2) per_cu = 2;
    if (per_cu < 1) per_cu = 1;
    grid_blocks = cus * per_cu;
  }
  P p{};
  for (int i = 0; i < 31; ++i) p.in[i] = (const float*)d_in[i];
  p.out = (float*)d_out;
  p.ws = (char*)d_ws;
  hipMemsetAsync((char*)d_ws + WS_BAR, 0, XCD_BAR_WORDS * sizeof(unsigned), stream);
  void* args[] = {&p};
  hipError_t e = hipLaunchCooperativeKernel((void*)mega, dim3(grid_blocks), dim3(256), args, 0, stream);
  if (e != hipSuccess) fprintf(stderr, "cooperative launch failed: %s (grid %d)\n", hipGetErrorString(e), grid_blocks);
}
#ifdef SPLIT_TEST
__global__ void __launch_bounds__(256, 2) k_p0(P p) { __shared__ __attribute__((aligned(16))) char smem[SMEM_BYTES]; phase0(p, smem); }
__global__ void __launch_bounds__(256, 2) k_a(P p, int l) { phaseA(p, l); }
__global__ void __launch_bounds__(256, 2) k_b(P p, int l) { __shared__ __attribute__((aligned(16))) char smem[SMEM_BYTES]; phaseB(p, l, smem); }
__global__ void __launch_bounds__(256, 2) k_e(P p, int l) { __shared__ __attribute__((aligned(16))) char smem[SMEM_BYTES]; phaseE(p, l, smem); }
__global__ void __launch_bounds__(256, 2) k_cmla(P p, int l) { __shared__ __attribute__((aligned(16))) char smem[SMEM_BYTES]; c_mla_q(p, l, blockIdx.x, smem); c_mla_kv(p, l, blockIdx.x, smem); }
__global__ void __launch_bounds__(256, 2) k_ccache(P p, int l) { __shared__ __attribute__((aligned(16))) char smem[SMEM_BYTES]; c_cache(p, l, blockIdx.x, smem); }
__global__ void __launch_bounds__(256, 2) k_cssd(P p, int l) { __shared__ __attribute__((aligned(16))) char smem[SMEM_BYTES]; c_ssd(p, l, blockIdx.x, blockIdx.y, smem); }
__global__ void __launch_bounds__(256, 2) k_cgqa(P p, int l) { __shared__ __attribute__((aligned(16))) char smem[SMEM_BYTES]; c_gqa(p, l, blockIdx.x, smem); }
__global__ void __launch_bounds__(256, 2) k_cgla(P p, int l) { __shared__ __attribute__((aligned(16))) char smem[SMEM_BYTES]; c_gla(p, l, blockIdx.x, blockIdx.y, smem); }
__global__ void __launch_bounds__(256, 2) k_dattn(P p, int l) { __shared__ __attribute__((aligned(16))) char smem[SMEM_BYTES]; d_attn(p, blockIdx.y, 0, 0, 256 + 256 * l, blockIdx.x & 3, blockIdx.x >> 2, smem); }
__global__ void __launch_bounds__(256, 2) k_dgla(P p, int l) { __shared__ __attribute__((aligned(16))) char smem[SMEM_BYTES]; d_gla(p, l, blockIdx.x, blockIdx.y, smem); }
__global__ void __launch_bounds__(256, 2) k_dssd(P p, int l) { __shared__ __attribute__((aligned(16))) char smem[SMEM_BYTES]; d_ssd(p, l, blockIdx.x, blockIdx.y, smem); }
#endif
```

```cpp
#include <hip/hip_runtime.h>
#include <hip/hip_cooperative_groups.h>
#include <cstdio>
namespace cg = cooperative_groups;

typedef unsigned short u16;
using bf16x8 = __attribute__((ext_vector_type(8))) short;
using f32x4 = __attribute__((ext_vector_type(4))) float;
using u32x4 = __attribute__((ext_vector_type(4))) unsigned;
#define DI __device__ __forceinline__

static constexpr size_t WS_MOD = 0;
static constexpr size_t WS_BAR = 512ull << 10;
static constexpr size_t WS_WINT = 1ull << 20;
static constexpr size_t WS_WOUTT = WS_WINT + 2ull * 3072 * 1024 * 2;
static constexpr size_t WS_WUQT = WS_WOUTT + 2ull * 1024 * 1024 * 2;
static constexpr size_t WS_WUKVT = WS_WUQT + 2ull * 384 * 192 * 2;
static constexpr size_t WS_H = WS_WUKVT + 2ull * 512 * 128 * 2;
static constexpr size_t WS_U = WS_H + 12288ull * 1024 * 2;
static constexpr size_t WS_SIDE = WS_U + 12288ull * 3072 * 2;
static constexpr size_t WS_QG = WS_SIDE + 12288ull * 40 * 4;
static constexpr size_t WS_KG = WS_QG + 12288ull * 256 * 2;
static constexpr size_t WS_VGT = WS_KG + 13312ull * 128 * 2;
static constexpr size_t WS_QM = WS_VGT + 13312ull * 128 * 2;
static constexpr size_t WS_KM = WS_QM + 12288ull * 384 * 2;
static constexpr size_t WS_VMT = WS_KM + 13312ull * 384 * 2;
static constexpr size_t WS_XBC = WS_VMT + 13312ull * 256 * 2;
static constexpr size_t WS_GUPD = WS_XBC + 12288ull * 512 * 2;
static constexpr size_t WS_GDEC = WS_GUPD + 192ull * 2 * 4 * 2048 * 4;
static constexpr size_t WS_SST = WS_GDEC + 192ull * 2 * 4 * 32 * 4;
static constexpr size_t WS_SDEC = WS_SST + 192ull * 2 * 4 * 4096 * 4;
static constexpr size_t WS_SSQ = WS_SDEC + 192ull * 8 * 4;
static constexpr size_t WS_CBG = WS_SSQ + 12288ull * 2 * 4;
static constexpr size_t WS_END = WS_CBG + 768ull * 4160 * 4;

static constexpr int OUT_GK = 12582912;
static constexpr int OUT_GV = OUT_GK + 2097152;
static constexpr int OUT_CKV = OUT_GV + 2097152;
static constexpr int OUT_KR = OUT_CKV + 2097152;
static constexpr int OUT_SG = OUT_KR + 524288;
static constexpr int OUT_SS = OUT_SG + 1048576;

static constexpr int SMEM_BYTES = 73728;
#define EPS 1e-6f
#define QSC_G (0.125f * 1.44269504089f)

#define XB_TMO      128
#define XB_XCNT(j)  (256  + 64 * (j))
#define XB_XSUB(j)  (1280 + 64 * (j))
#define XB_XGEN(j)  (2304 + 64 * (j))
#define XB_TOP      3328
#define XB_TOPGEN   3392
#define XCD_BAR_WORDS 3456
#define XB_SPIN_CAP (1u << 18)
#define LAS __attribute__((address_space(3)))

__device__ __forceinline__ unsigned xb_ld(unsigned* p)              { return __hip_atomic_load(p, __ATOMIC_RELAXED, __HIP_MEMORY_SCOPE_AGENT); }
__device__ __forceinline__ unsigned xb_add(unsigned* p, unsigned v) { return __hip_atomic_fetch_add(p, v, __ATOMIC_RELAXED, __HIP_MEMORY_SCOPE_AGENT); }
__device__ __forceinline__ unsigned xb_xcc_id() { return (unsigned)__builtin_amdgcn_s_getreg((3 << 11) | 20) & 0xFu; }
#define XB_SPIN(cond, bar) do { unsigned _sp = 0; while (cond) { __builtin_amdgcn_s_sleep(1); \
    if ((++_sp & 255u) == 0u) { if (xb_ld(&(bar)[XB_TMO])) break; if (_sp > XB_SPIN_CAP) { atomicAdd(&(bar)[XB_TMO], 1u); break; } } } } while (0)

struct XcdBarrier {
    unsigned* bar; unsigned x;
    volatile LAS unsigned* st;
};

__device__ __forceinline__ XcdBarrier xcd_barrier_post(unsigned* bar, volatile LAS unsigned* st) {
    XcdBarrier b; b.bar = bar; b.x = xb_xcc_id(); b.st = st;
    if (threadIdx.x == 0) (void)xb_add(&bar[XB_XCNT(b.x)], 1u);
    return b;
}
__device__ __forceinline__ void xcd_barrier_complete(unsigned* bar, unsigned x, unsigned& nloc, unsigned& nx) {
    const unsigned G = gridDim.x * gridDim.y * gridDim.z;
    unsigned sum, cnt, mine, sp = 0u;
    for (;;) {
        sum = 0u; cnt = 0u; mine = 0u;
#pragma unroll
        for (unsigned j = 0; j < 16; ++j) { const unsigned c = xb_ld(&bar[XB_XCNT(j)]); sum += c; cnt += (c > 0u) ? 1u : 0u; mine = (j == x) ? c : mine; }
        if (sum == G) break;
        __builtin_amdgcn_s_sleep(1);
        if ((++sp & 255u) == 0u) { if (xb_ld(&bar[XB_TMO])) break; if (sp > XB_SPIN_CAP) { atomicAdd(&bar[XB_TMO], 1u); break; } }
    }
    nloc = mine > 0u ? mine : 1u; nx = cnt > 0u ? cnt : 1u;
}

__device__ __forceinline__ void xcd_barrier(const XcdBarrier& b) {
    asm volatile("s_waitcnt vmcnt(0)" ::: "memory");
    __syncthreads();
    if (threadIdx.x == 0) {
        unsigned* bar = b.bar;
        __builtin_amdgcn_s_waitcnt(0);
        unsigned nloc = b.st[0], nx = b.st[1];
        if (nloc == 0u) { xcd_barrier_complete(bar, b.x, nloc, nx); b.st[0] = nloc; b.st[1] = nx; }
        const unsigned old = xb_add(&bar[XB_XSUB(b.x)], 1u);
        const unsigned gen = old / nloc;
        if (old + 1u == (gen + 1u) * nloc) {
            __builtin_amdgcn_fence(__ATOMIC_RELEASE, "agent");
            asm volatile("s_waitcnt vmcnt(0)" ::: "memory");
            const unsigned og = xb_add(&bar[XB_TOP], 1u);
            const unsigned tg = og / nx;
            if (og + 1u == (tg + 1u) * nx) xb_add(&bar[XB_TOPGEN], 1u);
            else XB_SPIN(xb_ld(&bar[XB_TOPGEN]) == tg, bar);
            __builtin_amdgcn_fence(__ATOMIC_ACQUIRE, "agent");
            xb_add(&bar[XB_XGEN(b.x)], 1u);
            asm volatile("s_waitcnt vmcnt(0)" ::: "memory");
        } else {
            XB_SPIN(xb_ld(&bar[XB_XGEN(b.x)]) == gen, bar);
            __builtin_amdgcn_fence(__ATOMIC_ACQUIRE, "agent");
            asm volatile("s_waitcnt vmcnt(0)" ::: "memory");
        }
    }
    __syncthreads();
}


struct P {
  const float* in[31];
  float* out;
  char* ws;
};

DI int otid() { int t = threadIdx.x; asm volatile("" : "+v"(t)); return t; }
typedef float f32x2_t __attribute__((ext_vector_type(2)));
typedef __bf16 bf16x2_t __attribute__((ext_vector_type(2)));
DI u16 f2bf(float x) { return __builtin_bit_cast(u16, (__bf16)x); }
DI float bf2f(u16 v) { return __uint_as_float(((unsigned)v) << 16); }
DI unsigned pack2(float a, float b) { f32x2_t v = {a, b}; return __builtin_bit_cast(unsigned, __builtin_convertvector(v, bf16x2_t)); }
DI float lo2f(unsigned u) { return __uint_as_float(u << 16); }
DI float hi2f(unsigned u) { return __uint_as_float(u & 0xffff0000u); }
DI f32x4 mfma(bf16x8 a, bf16x8 b, f32x4 c) { return __builtin_amdgcn_mfma_f32_16x16x32_bf16(a, b, c, 0, 0, 0); }
DI bf16x8 ldfrag(const u16* ptr) { return *(const bf16x8*)ptr; }
DI float4 ntload4(const float4* ptr) { f32x4 v = __builtin_nontemporal_load((const f32x4*)ptr); return make_float4(v[0], v[1], v[2], v[3]); }
DI void ntstore4(float4* ptr, float4 v) { f32x4 t = {v.x, v.y, v.z, v.w}; __builtin_nontemporal_store(t, (f32x4*)ptr); }
DI float silu(float x) { return x / (1.f + __expf(-x)); }
DI void st4bf(u16* dst, float a, float b, float c, float d) { uint2 v; v.x = pack2(a, b); v.y = pack2(c, d); *(uint2*)dst = v; }
DI void ld4bf(const u16* src, float* o) { uint2 v = *(const uint2*)src; o[0] = lo2f(v.x); o[1] = hi2f(v.x); o[2] = lo2f(v.y); o[3] = hi2f(v.y); }
DI void ld8bf(const u16* src, float* o) { uint4 v = *(const uint4*)src; o[0] = lo2f(v.x); o[1] = hi2f(v.x); o[2] = lo2f(v.y); o[3] = hi2f(v.y); o[4] = lo2f(v.z); o[5] = hi2f(v.z); o[6] = lo2f(v.w); o[7] = hi2f(v.w); }
DI float wave_sum(float v) { for (int o = 32; o > 0; o >>= 1) v += __shfl_xor(v, o); return v; }
DI float grp16_sum(float v) { v += __shfl_xor(v, 1); v += __shfl_xor(v, 2); v += __shfl_xor(v, 4); v += __shfl_xor(v, 8); return v; }

DI float xmax16(float v) { auto r = __builtin_amdgcn_permlane16_swap(__float_as_uint(v), __float_as_uint(v), false, false); return fmaxf(__uint_as_float(r[0]), __uint_as_float(r[1])); }
DI float xmax32(float v) { auto r = __builtin_amdgcn_permlane32_swap(__float_as_uint(v), __float_as_uint(v), false, false); return fmaxf(__uint_as_float(r[0]), __uint_as_float(r[1])); }
DI float xsum16(float v) { auto r = __builtin_amdgcn_permlane16_swap(__float_as_uint(v), __float_as_uint(v), false, false); return __uint_as_float(r[0]) + __uint_as_float(r[1]); }
DI float xsum32(float v) { auto r = __builtin_amdgcn_permlane32_swap(__float_as_uint(v), __float_as_uint(v), false, false); return __uint_as_float(r[0]) + __uint_as_float(r[1]); }

DI float wave_incl_scan(float v, int lane) {
#pragma unroll
  for (int o = 1; o < 64; o <<= 1) { const float t = __shfl_up(v, o); if (lane >= o) v += t; }
  return v;
}

struct TI { int t0, n0, N, isctx, b, kvoff, nk, kvrow0, c, nc; };
DI TI tile_info(int tt) {
  TI t; t.t0 = tt * 64;
  if (tt < 128) { int seq = tt >> 2; t.n0 = (tt & 3) * 64; t.N = 256; t.isctx = 1; t.b = seq; t.kvoff = seq * 256; t.nk = 256; t.kvrow0 = t.kvoff + t.n0; }
  else { int q = tt - 128; t.b = q >> 5; t.n0 = (q & 31) * 64; t.N = 2048; t.isctx = 0; t.kvoff = 8192 + t.b * 2560; t.nk = 2560; t.kvrow0 = t.kvoff + 512 + t.n0; }
  t.c = t.n0 >> 6; t.nc = t.N >> 6;
  return t;
}

DI void p0_mod(const P& p, int job, char* smem) {
  float* sl = (float*)smem; float* red = sl + 3072;
  const int tid = otid();
#pragma unroll
  for (int i = 0; i < 12; ++i) {
    const int e = tid + 256 * i; const int cnd = e >> 10, k = e & 1023;
    const float v = cnd == 0 ? p.in[9][k] : p.in[2][(cnd - 1) * 1024 + k];
    sl[e] = silu(v);
  }
  __syncthreads();
  const int l = job / 192, c0 = (job % 192) * 16;
  const int ks = tid >> 2, cq = tid & 3;
  const float* w = p.in[10] + (size_t)l * 1024 * 3072 + c0 + cq * 4;
  f32x4 a0 = {0.f, 0.f, 0.f, 0.f}, a1 = a0, a2 = a0;
#pragma unroll
  for (int kk = 0; kk < 16; ++kk) {
    const int k = ks * 16 + kk;
    const f32x4 wv = __builtin_nontemporal_load((const f32x4*)(w + (size_t)k * 3072));
    a0 += wv * sl[k]; a1 += wv * sl[1024 + k]; a2 += wv * sl[2048 + k];
  }
  *(f32x4*)(red + (ks * 3 + 0) * 16 + cq * 4) = a0; *(f32x4*)(red + (ks * 3 + 1) * 16 + cq * 4) = a1; *(f32x4*)(red + (ks * 3 + 2) * 16 + cq * 4) = a2;
  __syncthreads();
  if (tid < 48) {
    const int cnd = tid >> 4, c2 = tid & 15; float s2 = 0;
#pragma unroll 8
    for (int k2 = 0; k2 < 64; ++k2) s2 += red[(k2 * 3 + cnd) * 16 + c2];
    s2 += p.in[11][l * 3072 + c0 + c2];
    ((float*)(p.ws + WS_MOD))[(l * 3 + cnd) * 3072 + c0 + c2] = s2;
  }
  __syncthreads();
}

DI void p0_transpose(const float* src, int K, int N, u16* dst, int tk, int tn, char* smem) {
  float* tile = (float*)smem;
  const int tid = otid(); const int k0 = tk * 64, n0 = tn * 64;
  f32x4 v[4];
#pragma unroll
  for (int i = 0; i < 4; ++i) {
    const int k = i * 16 + (tid >> 4), n = (tid & 15) * 4;
    v[i] = (n0 + n < N) ? __builtin_nontemporal_load((const f32x4*)(src + (size_t)(k0 + k) * N + n0 + n)) : (f32x4){0.f, 0.f, 0.f, 0.f};
  }
#pragma unroll
  for (int i = 0; i < 4; ++i) {
    const int k = i * 16 + (tid >> 4), n = (tid & 15) * 4;
    tile[k * 65 + n] = v[i][0]; tile[k * 65 + n + 1] = v[i][1]; tile[k * 65 + n + 2] = v[i][2]; tile[k * 65 + n + 3] = v[i][3];
  }
  __syncthreads();
  {
    const int n = tid >> 2, kq = (tid & 3) * 16;
    u32x4 o0, o1;
#pragma unroll
    for (int e = 0; e < 4; ++e) {
      o0[e] = pack2(tile[(kq + 2 * e) * 65 + n], tile[(kq + 2 * e + 1) * 65 + n]);
      o1[e] = pack2(tile[(kq + 8 + 2 * e) * 65 + n], tile[(kq + 8 + 2 * e + 1) * 65 + n]);
    }
    u16* d = dst + (size_t)(n0 + n) * K + k0 + kq;
    *(u32x4*)d = o0; *(u32x4*)(d + 8) = o1;
  }
  __syncthreads();
}

DI void phase0(const P& p, char* smem) {
  for (int job = blockIdx.x; job < 2500; job += gridDim.x) {
    if (job < 384) p0_mod(p, job, smem);
    else if (job < 384 + 1536) { int j = job - 384; int l = j / 768, r = j % 768; p0_transpose(p.in[14] + (size_t)l * 1024 * 2952, 1024, 2952, (u16*)(p.ws + WS_WINT) + (size_t)l * 3072 * 1024, r / 48, r % 48, smem); }
    else if (job < 1920 + 512) { int j = job - 1920; int l = j >> 8, r = j & 255; p0_transpose(p.in[15] + (size_t)l * 1024 * 1024, 1024, 1024, (u16*)(p.ws + WS_WOUTT) + (size_t)l * 1024 * 1024, r >> 4, r & 15, smem); }
    else if (job < 2432 + 36) { int j = job - 2432; int l = j / 18, r = j % 18; p0_transpose(p.in[23] + (size_t)l * 192 * 384, 192, 384, (u16*)(p.ws + WS_WUQT) + (size_t)l * 384 * 192, r / 6, r % 6, smem); }
    else { int j = job - 2468; int l = j >> 4, r = j & 15; p0_transpose(p.in[24] + (size_t)l * 128 * 512, 128, 512, (u16*)(p.ws + WS_WUKVT) + (size_t)l * 512 * 128, r >> 3, r & 7, smem); }
  }
}

DI void phaseA(const P& p, int l) {
  const int tidA = otid();
  const int lane = tidA & 63;
  const int gw = blockIdx.x * 4 + (tidA >> 6), nw = gridDim.x * 4;
  const float* MOD = (const float*)(p.ws + WS_MOD);
  const u16* O = (const u16*)(p.ws + WS_U);
  u16* H = (u16*)(p.ws + WS_H);
  float4 xn[4]; uint2 on[4];
  {
    const int row = gw;
    if (row < 12288) {
      const float* xin = (l <= 1) ? (row < 8192 ? p.in[0] + (size_t)row * 1024 : p.in[1] + (size_t)(row - 8192) * 1024) : p.out + (size_t)row * 1024;
#pragma unroll
      for (int i = 0; i < 4; ++i) { xn[i] = ntload4(((const float4*)xin) + i * 64 + lane); if (l > 0) on[i] = ((const uint2*)(O + (size_t)row * 1024))[i * 64 + lane]; }
    }
  }
  for (int row = gw; row < 12288; row += nw) {
    const int cond = row < 8192 ? 0 : 1 + ((row - 8192) >> 11);
    float4 x[4], o[4];
#pragma unroll
    for (int i = 0; i < 4; ++i) { x[i] = xn[i]; o[i] = make_float4(lo2f(on[i].x), hi2f(on[i].x), lo2f(on[i].y), hi2f(on[i].y)); }
    {
      const int rown = row + nw;
      if (rown < 12288) {
        const float* xin = (l <= 1) ? (rown < 8192 ? p.in[0] + (size_t)rown * 1024 : p.in[1] + (size_t)(rown - 8192) * 1024) : p.out + (size_t)rown * 1024;
#pragma unroll
        for (int i = 0; i < 4; ++i) { xn[i] = ntload4(((const float4*)xin) + i * 64 + lane); if (l > 0) on[i] = ((const uint2*)(O + (size_t)rown * 1024))[i * 64 + lane]; }
      }
    }
    if (l > 0) {
      float ss = 0;
#pragma unroll
      for (int i = 0; i < 4; ++i) ss += o[i].x * o[i].x + o[i].y * o[i].y + o[i].z * o[i].z + o[i].w * o[i].w;
      ss = wave_sum(ss);
      const float rr = rsqrtf(ss * (1.f / 1024.f) + EPS);
      const float* gate = MOD + ((l - 1) * 3 + cond) * 3072 + 2048;
      const float* np = p.in[13] + (l - 1) * 1024;
#pragma unroll
      for (int i = 0; i < 4; ++i) {
        float4 g4 = ((const float4*)gate)[i * 64 + lane], n4 = ((const float4*)np)[i * 64 + lane];
        x[i].x += g4.x * (o[i].x * rr * n4.x); x[i].y += g4.y * (o[i].y * rr * n4.y);
        x[i].z += g4.z * (o[i].z * rr * n4.z); x[i].w += g4.w * (o[i].w * rr * n4.w);
        ntstore4(((float4*)(p.out + (size_t)row * 1024)) + i * 64 + lane, x[i]);
      }
    }
    if (l < 2) {
      float ss = 0;
#pragma unroll
      for (int i = 0; i < 4; ++i) ss += x[i].x * x[i].x + x[i].y * x[i].y + x[i].z * x[i].z + x[i].w * x[i].w;
      ss = wave_sum(ss);
      const float rr = rsqrtf(ss * (1.f / 1024.f) + EPS);
      const float* sh = MOD + (l * 3 + cond) * 3072; const float* sc = sh + 1024;
      const float* np = p.in[12] + l * 1024;
#pragma unroll
      for (int i = 0; i < 4; ++i) {
        float4 s4 = ((const float4*)sh)[i * 64 + lane], c4 = ((const float4*)sc)[i * 64 + lane], n4 = ((const float4*)np)[i * 64 + lane];
        st4bf(H + (size_t)row * 1024 + i * 256 + lane * 4,
              x[i].x * rr * n4.x * (1.f + c4.x) + s4.x, x[i].y * rr * n4.y * (1.f + c4.y) + s4.y,
              x[i].z * rr * n4.z * (1.f + c4.z) + s4.z, x[i].w * rr * n4.w * (1.f + c4.w) + s4.w);
      }
    }
  }
}

template <int MODE>
DI void gemm_tile(const u16* __restrict__ A, const u16* __restrict__ Bt, int mt, int nt, char* cout, float* side, char* smem) {
  u16* As = (u16*)smem;
  const int tid = otid(), lane = tid & 63, w = tid >> 6, r = lane & 15, g = lane >> 4;
  const int wm = w & 1, wn = w >> 1;
  constexpr int TI = MODE == 1 ? 3 : 4;
  constexpr int BMT = TI * 32, WMT = TI * 16;
  const u16* Ag = A + (size_t)(mt * BMT) * 1024;
  const u16* Bg = Bt + (size_t)(nt * 128) * 1024;
  f32x4 acc[4][TI];
#pragma unroll
  for (int i = 0; i < 4; ++i)
#pragma unroll
    for (int j = 0; j < TI; ++j) acc[i][j] = (f32x4){0.f, 0.f, 0.f, 0.f};
  u32x4 ra[2][TI], rb[2][4];
  float rrow[TI];
  if (MODE == 1) {
#pragma unroll
    for (int ti = 0; ti < TI; ++ti) { const float2 q = *(const float2*)(side + (size_t)(mt * BMT + wm * WMT + ti * 16 + r) * 2); rrow[ti] = rsqrtf((q.x + q.y) * (1.f / 256.f) + EPS); }
  }
  const int lrow = tid >> 3, lch = (tid & 7) * 8;
  const int lsw = ((tid & 7) ^ ((lrow >> 1) & 7)) * 8;
  const int rsw = (r >> 1) & 7;
#define G_LOAD(SET, KT) { _Pragma("unroll") for (int i = 0; i < 4; ++i) { if (i < TI) ra[SET][i < TI ? i : 0] = *(const u32x4*)(Ag + (size_t)(lrow + 32 * i) * 1024 + (KT) * 64 + lch); rb[SET][i] = *(const u32x4*)(Bg + (size_t)(lrow + 32 * i) * 1024 + (KT) * 64 + lch); } }
#define G_STORE(SET, BUFI) { u16* as_ = As + (BUFI) * (256 * 64); u16* bs_ = as_ + 128 * 64; _Pragma("unroll") for (int i = 0; i < 4; ++i) { if (i < TI) *(u32x4*)(as_ + (lrow + 32 * i) * 64 + lsw) = ra[SET][i < TI ? i : 0]; *(u32x4*)(bs_ + (lrow + 32 * i) * 64 + lsw) = rb[SET][i]; } }
#define G_COMPUTE(BUFI) { const u16* as_ = As + (BUFI) * (256 * 64); const u16* bs_ = as_ + 128 * 64; \
    _Pragma("unroll") for (int s = 0; s < 2; ++s) { bf16x8 wf[4], xf[TI]; const int co = ((s * 4 + g) ^ rsw) * 8; \
      _Pragma("unroll") for (int i = 0; i < 4; ++i) { wf[i] = ldfrag(bs_ + (wn * 64 + i * 16 + r) * 64 + co); if (i < TI) xf[i < TI ? i : 0] = ldfrag(as_ + (wm * WMT + i * 16 + r) * 64 + co); } \
      __builtin_amdgcn_s_setprio(1); \
      _Pragma("unroll") for (int ni = 0; ni < 4; ++ni) _Pragma("unroll") for (int ti = 0; ti < TI; ++ti) acc[ni][ti] = mfma(wf[ni], xf[ti], acc[ni][ti]); \
      __builtin_amdgcn_s_setprio(0); } }
  G_LOAD(0, 0)
  G_LOAD(1, 1)
  G_STORE(0, 0)
  __syncthreads();
  for (int kt = 0; kt < 16; kt += 2) {
    if (MODE == 1 && kt == 12) {
#pragma unroll
      for (int ni = 0; ni < 4; ++ni)
#pragma unroll
        for (int ti = 0; ti < TI; ++ti) acc[ni][ti] = acc[ni][ti] * (1.f / rrow[ti]);
    }
    if (kt + 2 < 16) G_LOAD(0, kt + 2)
    G_COMPUTE(0)
    G_STORE(1, 1)
    __syncthreads();
    if (kt + 3 < 16) G_LOAD(1, kt + 3)
    G_COMPUTE(1)
    if (kt + 2 < 16) G_STORE(0, 0)
    __syncthreads();
  }
#undef G_LOAD
#undef G_STORE
#undef G_COMPUTE
  u16* Cs = (u16*)smem;
#pragma unroll
  for (int ni = 0; ni < 4; ++ni)
#pragma unroll
    for (int ti = 0; ti < TI; ++ti) {
      f32x4 v = acc[ni][ti];
      if (MODE == 0) {
        const int tok = mt * BMT + wm * WMT + ti * 16 + r;
        const int n = nt * 128 + wn * 64 + ni * 16 + g * 4;
        if (n >= 1280 && n < 1312) *(float4*)(side + (size_t)tok * 40 + (n - 1280)) = make_float4(v[0], v[1], v[2], v[3]);
        if (n >= 2944 && n < 2952) *(float4*)(side + (size_t)tok * 40 + 32 + (n - 2944)) = make_float4(v[0], v[1], v[2], v[3]);
      } else {
        v = v * rrow[ti];
      }
      st4bf(Cs + (wm * WMT + ti * 16 + r) * 136 + wn * 64 + ni * 16 + g * 4, v[0], v[1], v[2], v[3]);
    }
  __syncthreads();
  {
    constexpr int LDC = MODE == 0 ? 3072 : 1024;
    u16* outp = (u16*)cout + (size_t)(mt * BMT) * LDC + nt * 128;
#pragma unroll
    for (int i = 0; i < TI * 2; ++i) {
      const int idx = tid + 256 * i, row = idx >> 4, chk = idx & 15;
      *(u32x4*)(outp + (size_t)row * LDC + chk * 8) = *(const u32x4*)(Cs + row * 136 + chk * 8);
    }
  }
  __syncthreads();
}

DI void vt_store_tile(const u16* tile, u16* vt_base, int nk, int key0) {
  const int tid = otid(), seg = tid & 7;
#pragma unroll
  for (int it = 0; it < 4; ++it) {
    const int c = it * 32 + (tid >> 3);
    u32x4 o;
#pragma unroll
    for (int e = 0; e < 4; ++e) o[e] = (unsigned)tile[(seg * 8 + 2 * e) * 136 + c] | ((unsigned)tile[(seg * 8 + 2 * e + 1) * 136 + c] << 16);
    *(u32x4*)(vt_base + (size_t)c * nk + key0 + seg * 8) = o;
  }
}

DI void c_gqa(const P& p, int l, int tt, char* smem) {
  const TI ti = tile_info(tt);
  const u16* U = (const u16*)(p.ws + WS_U);
  u16* Qg = (u16*)(p.ws + WS_QG); u16* Kg = (u16*)(p.ws + WS_KG); u16* VgT = (u16*)(p.ws + WS_VGT);
  const int tid = otid(), grp = tid >> 4, li = tid & 15;
  const float* qn = p.in[16] + l * 64; const float* kn = p.in[17] + l * 64;
  for (int itb = 0; itb < 24; itb += 4) {
    uint2 xraw[4];
#pragma unroll
    for (int k = 0; k < 4; ++k) { const int u = (itb + k) * 16 + grp; xraw[k] = *(const uint2*)(U + (size_t)(ti.t0 + u / 6) * 3072 + (u % 6) * 64 + li * 4); }
#pragma unroll
    for (int k = 0; k < 4; ++k) {
      const int u = (itb + k) * 16 + grp; const int tok = u / 6, hh = u % 6;
      const int t = ti.t0 + tok, n = ti.n0 + tok;
      float x[4] = {lo2f(xraw[k].x), hi2f(xraw[k].x), lo2f(xraw[k].y), hi2f(xraw[k].y)};
      float ss = x[0] * x[0] + x[1] * x[1] + x[2] * x[2] + x[3] * x[3];
      ss = grp16_sum(ss);
      const float rr = rsqrtf(ss * (1.f / 64.f) + EPS);
      const float* gn = hh < 4 ? qn : kn;
      float y[4];
#pragma unroll
      for (int i = 0; i < 4; ++i) y[i] = x[i] * rr * gn[li * 4 + i];
      if (hh >= 4 && ti.isctx) *(float4*)(p.out + OUT_GK + ((size_t)((ti.b * 2 + l) * 256 + n) * 2 + (hh - 4)) * 64 + li * 4) = make_float4(y[0], y[1], y[2], y[3]);
      if (!ti.isctx) {
        const int axis = li >> 3, half = (li >> 2) & 1;
        const float pos = (float)(axis == 0 ? (n >> 6) : (n & 63));
#pragma unroll
        for (int i = 0; i < 4; ++i) {
          const int f = (li & 3) * 4 + i;
          const float ang = pos * exp2f(-(float)f * 0.83048202372f);
          const float cs = __cosf(ang), sn = __sinf(ang);
          const float pr = __shfl_xor(y[i], 4);
          y[i] = half == 0 ? y[i] * cs - pr * sn : y[i] * cs + pr * sn;
        }
      }
      if (hh < 4) st4bf(Qg + (size_t)t * 256 + hh * 64 + li * 4, y[0] * QSC_G, y[1] * QSC_G, y[2] * QSC_G, y[3] * QSC_G);
      else st4bf(Kg + (size_t)(ti.kvrow0 + tok) * 128 + (hh - 4) * 64 + li * 4, y[0], y[1], y[2], y[3]);
    }
  }
  {
    u16* tile = (u16*)smem;
    const int tok = tid >> 2, cq = tid & 3; const int t = ti.t0 + tok, n = ti.n0 + tok;
    u32x4 vraw[4];
#pragma unroll
    for (int j4 = 0; j4 < 4; ++j4) vraw[j4] = *(const u32x4*)(U + (size_t)t * 3072 + 384 + cq * 32 + j4 * 8);
#pragma unroll
    for (int j4 = 0; j4 < 4; ++j4) {
      *(u32x4*)(tile + tok * 136 + cq * 32 + j4 * 8) = vraw[j4];
      if (ti.isctx) {
        float* o = p.out + OUT_GV + (size_t)((ti.b * 2 + l) * 256 + n) * 128 + cq * 32 + j4 * 8;
        *(float4*)o = make_float4(lo2f(vraw[j4][0]), hi2f(vraw[j4][0]), lo2f(vraw[j4][1]), hi2f(vraw[j4][1]));
        *(float4*)(o + 4) = make_float4(lo2f(vraw[j4][2]), hi2f(vraw[j4][2]), lo2f(vraw[j4][3]), hi2f(vraw[j4][3]));
      }
    }
    __syncthreads();
    vt_store_tile(tile, VgT + (size_t)ti.kvoff * 128, ti.nk, ti.kvrow0 - ti.kvoff);
    __syncthreads();
  }
}

DI void mla_kv_up(const u16* Ackv, const u16* __restrict__ WukvT, u16* Km, u16* VmT, int kvrow0, int kvoff, int nk) {
  const int tid = otid(), lane = tid & 63, w = tid >> 6, r = lane & 15, g = lane >> 4;
  const int h = w;
  bf16x8 wn[4];
#pragma unroll
  for (int s = 0; s < 4; ++s) wn[s] = ldfrag(WukvT + (size_t)(h * 128 + r) * 128 + s * 32 + g * 8);
  for (int sub = 0; sub < 8; ++sub) {
    bf16x8 wf[4];
#pragma unroll
    for (int s = 0; s < 4; ++s) wf[s] = wn[s];
    if (sub < 7) {
#pragma unroll
      for (int s = 0; s < 4; ++s) wn[s] = ldfrag(WukvT + (size_t)(h * 128 + (sub + 1) * 16 + r) * 128 + s * 32 + g * 8);
    }
#pragma unroll
    for (int t4 = 0; t4 < 4; ++t4) {
      f32x4 acc = (f32x4){0.f, 0.f, 0.f, 0.f};
      if (sub < 4) {
#pragma unroll
        for (int s = 0; s < 4; ++s) acc = mfma(wf[s], ldfrag(Ackv + (t4 * 16 + r) * 136 + s * 32 + g * 8), acc);
        st4bf(Km + (size_t)(kvrow0 + t4 * 16 + r) * 384 + h * 96 + sub * 16 + g * 4, acc[0], acc[1], acc[2], acc[3]);
      } else {
#pragma unroll
        for (int s = 0; s < 4; ++s) acc = mfma(ldfrag(Ackv + (t4 * 16 + r) * 136 + s * 32 + g * 8), wf[s], acc);
        const int dv = (sub - 4) * 16 + r;
        st4bf(VmT + (size_t)kvoff * 256 + (size_t)(h * 64 + dv) * nk + (kvrow0 - kvoff) + t4 * 16 + g * 4, acc[0], acc[1], acc[2], acc[3]);
      }
    }
  }
}

DI void c_mla_q(const P& p, int l, int tt, char* smem) {
  const TI ti = tile_info(tt);
  const u16* U = (const u16*)(p.ws + WS_U);
  u16* Qm = (u16*)(p.ws + WS_QM);
  u16* Acq = (u16*)smem;
  const int tid = otid(), grp = tid >> 4, li = tid & 15;
  const float* qn = p.in[21] + l * 192;
  {
    uint2 raw[4][3];
#pragma unroll
    for (int it = 0; it < 4; ++it)
#pragma unroll
      for (int k = 0; k < 3; ++k) raw[it][k] = *(const uint2*)(U + (size_t)(ti.t0 + it * 16 + grp) * 3072 + 1568 + li * 12 + k * 4);
#pragma unroll
    for (int it = 0; it < 4; ++it) {
      const int tok = it * 16 + grp;
      float x[12];
#pragma unroll
      for (int k = 0; k < 3; ++k) { x[k * 4] = lo2f(raw[it][k].x); x[k * 4 + 1] = hi2f(raw[it][k].x); x[k * 4 + 2] = lo2f(raw[it][k].y); x[k * 4 + 3] = hi2f(raw[it][k].y); }
      float ss = 0;
#pragma unroll
      for (int i = 0; i < 12; ++i) ss += x[i] * x[i];
      ss = grp16_sum(ss);
      const float rr = rsqrtf(ss * (1.f / 192.f) + EPS);
#pragma unroll
      for (int i = 0; i < 12; i += 4) st4bf(Acq + tok * 200 + li * 12 + i, x[i] * rr * qn[li * 12 + i], x[i + 1] * rr * qn[li * 12 + i + 1], x[i + 2] * rr * qn[li * 12 + i + 2], x[i + 3] * rr * qn[li * 12 + i + 3]);
    }
  }
  __syncthreads();
  {
    const int lane = tid & 63, w = tid >> 6, r = lane & 15, g = lane >> 4;
    const u16* WuqT = (const u16*)(p.ws + WS_WUQT) + (size_t)l * 384 * 192;
    bf16x8 wn[6];
#pragma unroll
    for (int s = 0; s < 6; ++s) wn[s] = ldfrag(WuqT + (size_t)(w * 96 + r) * 192 + s * 32 + g * 8);
    for (int sub = 0; sub < 6; ++sub) {
      bf16x8 wf[6];
#pragma unroll
      for (int s = 0; s < 6; ++s) wf[s] = wn[s];
      if (sub < 5) {
#pragma unroll
        for (int s = 0; s < 6; ++s) wn[s] = ldfrag(WuqT + (size_t)(w * 96 + (sub + 1) * 16 + r) * 192 + s * 32 + g * 8);
      }
#pragma unroll
      for (int t4 = 0; t4 < 4; ++t4) {
        f32x4 acc = (f32x4){0.f, 0.f, 0.f, 0.f};
#pragma unroll
        for (int s = 0; s < 6; ++s) acc = mfma(wf[s], ldfrag(Acq + (t4 * 16 + r) * 200 + s * 32 + g * 8), acc);
        float y[4] = {acc[0], acc[1], acc[2], acc[3]};
        if (sub >= 4 && !ti.isctx) {
          const int n = ti.n0 + t4 * 16 + r;
          const int axis = sub - 4, half = g >> 1;
          const float pos = (float)(axis == 0 ? (n >> 6) : (n & 63));
#pragma unroll
          for (int i = 0; i < 4; ++i) {
            const int f = (g & 1) * 4 + i;
            const float ang = pos * exp2f(-(float)f * 1.66096404744f);
            const float cs = __cosf(ang), sn = __sinf(ang);
            const float pr = __shfl_xor(y[i], 32);
            y[i] = half == 0 ? y[i] * cs - pr * sn : y[i] * cs + pr * sn;
          }
        }
        const float sc = 0.10206207262f * 1.44269504089f;
        st4bf(Qm + (size_t)(ti.t0 + t4 * 16 + r) * 384 + w * 96 + sub * 16 + g * 4, y[0] * sc, y[1] * sc, y[2] * sc, y[3] * sc);
      }
    }
  }
  __syncthreads();
}

DI void c_mla_kv(const P& p, int l, int tt, char* smem) {
  const TI ti = tile_info(tt);
  const u16* U = (const u16*)(p.ws + WS_U);
  u16* Km = (u16*)(p.ws + WS_KM); u16* VmT = (u16*)(p.ws + WS_VMT);
  u16* Ackv = (u16*)smem;
  const int tid = otid(), grp = tid >> 4, li = tid & 15;
  const float* kvn = p.in[22] + l * 128;
  {
    u32x4 rawc[4]; unsigned rawk[4];
#pragma unroll
    for (int it = 0; it < 4; ++it) {
      rawc[it] = *(const u32x4*)(U + (size_t)(ti.t0 + it * 16 + grp) * 3072 + 1760 + li * 8);
      rawk[it] = *(const unsigned*)(U + (size_t)(ti.t0 + it * 16 + grp) * 3072 + 1888 + li * 2);
    }
#pragma unroll
    for (int it = 0; it < 4; ++it) {
      const int tok = it * 16 + grp; const int n = ti.n0 + tok;
      {
        float x[8];
#pragma unroll
        for (int e = 0; e < 4; ++e) { x[e * 2] = lo2f(rawc[it][e]); x[e * 2 + 1] = hi2f(rawc[it][e]); }
        float ss = 0;
#pragma unroll
        for (int i = 0; i < 8; ++i) ss += x[i] * x[i];
        ss = grp16_sum(ss);
        const float rr = rsqrtf(ss * (1.f / 128.f) + EPS);
#pragma unroll
        for (int i = 0; i < 8; ++i) x[i] = x[i] * rr * kvn[li * 8 + i];
        if (ti.isctx) { float* o = p.out + OUT_CKV + (size_t)((ti.b * 2 + l) * 256 + n) * 128 + li * 8; *(float4*)o = make_float4(x[0], x[1], x[2], x[3]); *(float4*)(o + 4) = make_float4(x[4], x[5], x[6], x[7]); }
        st4bf(Ackv + tok * 136 + li * 8, x[0], x[1], x[2], x[3]); st4bf(Ackv + tok * 136 + li * 8 + 4, x[4], x[5], x[6], x[7]);
      }
      {
        float y[2] = {lo2f(rawk[it]), hi2f(rawk[it])};
        if (ti.isctx) *(float2*)(p.out + OUT_KR + (size_t)((ti.b * 2 + l) * 256 + n) * 32 + li * 2) = make_float2(y[0], y[1]);
        else {
          const int axis = li >> 3, half = (li >> 2) & 1;
          const float pos = (float)(axis == 0 ? (n >> 6) : (n & 63));
#pragma unroll
          for (int e = 0; e < 2; ++e) {
            const int f = (li & 3) * 2 + e;
            const float ang = pos * exp2f(-(float)f * 1.66096404744f);
            const float cs = __cosf(ang), sn = __sinf(ang);
            const float pr = __shfl_xor(y[e], 4);
            y[e] = half == 0 ? y[e] * cs - pr * sn : y[e] * cs + pr * sn;
          }
        }
        const unsigned pk = pack2(y[0], y[1]);
#pragma unroll
        for (int h = 0; h < 4; ++h) *(unsigned*)(Km + (size_t)(ti.kvrow0 + tok) * 384 + h * 96 + 64 + li * 2) = pk;
      }
    }
  }
  __syncthreads();
  mla_kv_up(Ackv, (const u16*)(p.ws + WS_WUKVT) + (size_t)l * 512 * 128, Km, VmT, ti.kvrow0, ti.kvoff, ti.nk);
  __syncthreads();
}

DI void c_cache(const P& p, int l, int job, char* smem) {
  const int b = job >> 3, j0 = (job & 7) * 64;
  const int kvoff = 8192 + b * 2560, nk = 2560, kvrow0 = kvoff + j0;
  u16* Kg = (u16*)(p.ws + WS_KG); u16* VgT = (u16*)(p.ws + WS_VGT); u16* Km = (u16*)(p.ws + WS_KM); u16* VmT = (u16*)(p.ws + WS_VMT);
  u16* Ackv = (u16*)smem;
  const int tid = otid(), grp = tid >> 4, li = tid & 15;
  const size_t cbase = (size_t)(b * 2 + l) * 512 + j0;
  for (int it = 0; it < 4; ++it) {
    const int tok = it * 16 + grp;
    const float* src = p.in[5] + (cbase + tok) * 128 + li * 8;
    float4 a = *(const float4*)src, c = *(const float4*)(src + 4);
    st4bf(Ackv + tok * 136 + li * 8, a.x, a.y, a.z, a.w); st4bf(Ackv + tok * 136 + li * 8 + 4, c.x, c.y, c.z, c.w);
    float2 kr = *(const float2*)(p.in[6] + (cbase + tok) * 32 + li * 2);
    const unsigned pk = pack2(kr.x, kr.y);
#pragma unroll
    for (int h = 0; h < 4; ++h) *(unsigned*)(Km + (size_t)(kvrow0 + tok) * 384 + h * 96 + 64 + li * 2) = pk;
  }
  u16* vtile = Ackv + 64 * 136;
#pragma unroll
  for (int i = 0; i < 8; ++i) {
    const int idx = tid + 256 * i, row = idx >> 5, c4 = (idx & 31) * 4;
    const float4 kv = *(const float4*)(p.in[3] + (cbase + row) * 128 + c4);
    st4bf(Kg + (size_t)(kvrow0 + row) * 128 + c4, kv.x, kv.y, kv.z, kv.w);
    const float4 vv = *(const float4*)(p.in[4] + (cbase + row) * 128 + c4);
    st4bf(vtile + row * 136 + c4, vv.x, vv.y, vv.z, vv.w);
  }
  __syncthreads();
  vt_store_tile(vtile, VgT + (size_t)kvoff * 128, nk, j0);
  mla_kv_up(Ackv, (const u16*)(p.ws + WS_WUKVT) + (size_t)l * 512 * 128, Km, VmT, kvrow0, kvoff, nk);
  __syncthreads();
}

DI void gla_logg_cum(const P& p, int l, int t0, int h, float* CB, float* TT) {
  const int tid = otid(), tok = tid >> 2, dsub = tid & 3;
  const float* SIDE = (const float*)(p.ws + WS_SIDE);
  for (int dir = 0; dir < 2; ++dir) {
    const float* gl = SIDE + (size_t)(t0 + tok) * 40 + dir * 16;
    float glr[16];
#pragma unroll
    for (int i = 0; i < 4; ++i) { float4 v = ((const float4*)gl)[i]; glr[i * 4] = v.x; glr[i * 4 + 1] = v.y; glr[i * 4 + 2] = v.z; glr[i * 4 + 3] = v.w; }
    float acc[8];
    const float* bg = p.in[19] + (l * 2 + dir) * 128 + h * 32 + dsub * 8;
#pragma unroll
    for (int e = 0; e < 8; ++e) acc[e] = bg[e];
#pragma unroll
    for (int r = 0; r < 16; ++r) {
      const float* wr = p.in[18] + (size_t)((l * 2 + dir) * 16 + r) * 128 + h * 32 + dsub * 8;
      float4 w0 = *(const float4*)wr, w1 = *(const float4*)(wr + 4);
      acc[0] += glr[r] * w0.x; acc[1] += glr[r] * w0.y; acc[2] += glr[r] * w0.z; acc[3] += glr[r] * w0.w;
      acc[4] += glr[r] * w1.x; acc[5] += glr[r] * w1.y; acc[6] += glr[r] * w1.z; acc[7] += glr[r] * w1.w;
    }
#pragma unroll
    for (int e = 0; e < 8; ++e) {
      const float x = acc[e];
      const float ls = fminf(x, 0.f) - 0.69314718056f * __log2f(1.f + __builtin_amdgcn_exp2f(-1.44269504089f * fabsf(x)));
      CB[(dir * 64 + tok) * 32 + dsub * 8 + e] = ls * (1.f / 16.f);
    }
  }
  __syncthreads();
  {
    const int lane = tid & 63, w = tid >> 6;
#pragma unroll 4
    for (int i = 0; i < 16; ++i) {
      const int col = w * 16 + i, dir = col >> 5, d = col & 31;
      const int j = dir ? 63 - lane : lane;
      float v = CB[(dir * 64 + j) * 32 + d];
      v = wave_incl_scan(v, lane);
      CB[(dir * 64 + j) * 32 + d] = v;
      if (lane == 63) TT[col] = v;
    }
  }
  __syncthreads();
}

DI void c_gla(const P& p, int l, int tt, int h, char* smem) {
  const int t0 = tt * 64;
  float* CB = (float*)smem; float* TT = CB + 4096;
  u16* KoutT = (u16*)(TT + 64); u16* VT = KoutT + 64 * 72;
  const u16* U = (const u16*)(p.ws + WS_U);
  const int tid = otid();
  gla_logg_cum(p, l, t0, h, CB, TT);
  {
    float* dst = (float*)(p.ws + WS_CBG) + (size_t)(tt * 4 + h) * 4160;
#pragma unroll
    for (int i = 0; i < 4; ++i) *(float4*)(dst + (tid + 256 * i) * 4) = *(const float4*)(CB + (tid + 256 * i) * 4);
    if (tid < 16) *(float4*)(dst + 4096 + tid * 4) = *(const float4*)(TT + tid * 4);
  }
  {
    const int tok = tid >> 2, sub = tid & 3;
    float k[8]; ld8bf(U + (size_t)(t0 + tok) * 3072 + 896 + h * 32 + sub * 8, k);
#pragma unroll
    for (int dir = 0; dir < 2; ++dir)
#pragma unroll
      for (int e = 0; e < 8; ++e) { const int d = sub * 8 + e; KoutT[(dir * 32 + d) * 72 + tok] = f2bf(k[e] * __expf(TT[dir * 32 + d] - CB[(dir * 64 + tok) * 32 + d])); }
    const u16* vs = U + (size_t)(t0 + tok) * 3072 + 1024 + h * 64 + sub * 16;
    u32x4 v0 = *(const u32x4*)vs, v1 = *(const u32x4*)(vs + 8);
#pragma unroll
    for (int e = 0; e < 4; ++e) {
      VT[(sub * 16 + e * 2) * 72 + tok] = (u16)(v0[e] & 0xffffu); VT[(sub * 16 + e * 2 + 1) * 72 + tok] = (u16)(v0[e] >> 16);
      VT[(sub * 16 + 8 + e * 2) * 72 + tok] = (u16)(v1[e] & 0xffffu); VT[(sub * 16 + 8 + e * 2 + 1) * 72 + tok] = (u16)(v1[e] >> 16);
    }
  }
  __syncthreads();
  {
    const int lane = tid & 63, w = tid >> 6, r = lane & 15, g = lane >> 4;
    const int dir = w >> 1, dt = w & 1;
    float* UPD = (float*)(p.ws + WS_GUPD) + (size_t)((tt * 2 + dir) * 4 + h) * 2048;
    bf16x8 b0 = ldfrag(KoutT + (dir * 32 + dt * 16 + r) * 72 + g * 8), b1 = ldfrag(KoutT + (dir * 32 + dt * 16 + r) * 72 + 32 + g * 8);
#pragma unroll
    for (int et = 0; et < 4; ++et) {
      f32x4 acc = (f32x4){0.f, 0.f, 0.f, 0.f};
      acc = mfma(ldfrag(VT + (et * 16 + r) * 72 + g * 8), b0, acc);
      acc = mfma(ldfrag(VT + (et * 16 + r) * 72 + 32 + g * 8), b1, acc);
      *(float4*)(UPD + (dt * 16 + r) * 64 + et * 16 + g * 4) = make_float4(acc[0], acc[1], acc[2], acc[3]);
    }
    if (tid < 64) ((float*)(p.ws + WS_GDEC))[((tt * 2 + (tid >> 5)) * 4 + h) * 32 + (tid & 31)] = __expf(TT[tid]);
  }
  __syncthreads();
}

DI float softplus(float x) { return x > 20.f ? x : log1pf(__expf(x)); }

DI void c_ssd(const P& p, int l, int tt, int grp, char* smem) {
  const TI ti = tile_info(tt);
  const int t0 = ti.t0;
  u16* XsT = (u16*)smem;
  u16* BwT = XsT + 128 * 72;
  float* DT = (float*)(BwT + 4 * 64 * 72);
  float* CUM = DT + 256; float* WJ = CUM + 256; float* TOT = WJ + 256;
  const u16* U = (const u16*)(p.ws + WS_U);
  const float* SIDE = (const float*)(p.ws + WS_SIDE);
  u16* XBC = (u16*)(p.ws + WS_XBC);
  const int tid = otid();
  {
    const int tok = tid & 63, combo = tid >> 6, dir = combo >> 1, head = grp * 2 + (combo & 1);
    const float raw = SIDE[(size_t)(t0 + tok) * 40 + 32 + dir * 4 + head] + p.in[27][(l * 2 + dir) * 4 + head];
    const float dt = softplus(raw);
    DT[tid] = dt; CUM[tid] = -__expf(p.in[28][(l * 2 + dir) * 4 + head]) * dt;
  }
  __syncthreads();
  {
    const int lane = tid & 63, w = tid >> 6, dir = w >> 1;
    const int j = dir ? 63 - lane : lane;
    float v = CUM[w * 64 + j];
    v = wave_incl_scan(v, lane);
    CUM[w * 64 + j] = v;
    if (lane == 63) TOT[w] = v;
  }
  __syncthreads();
  WJ[tid] = DT[tid] * __expf(TOT[tid >> 6] - CUM[tid]);
  __syncthreads();
  {
    const int co = tid & 31, tg = tid >> 5;
    int ch;
    if (co < 16) ch = grp * 128 + co * 8; else if (co < 24) ch = 256 + grp * 64 + (co - 16) * 8; else ch = 384 + grp * 64 + (co - 24) * 8;
    const int jb = tg * 8;
    u32x4 xr[12];
#pragma unroll
    for (int w = 0; w < 12; ++w) {
      const int n = ti.n0 + jb + w - 2;
      xr[w] = (n >= 0 && n < ti.N) ? *(const u32x4*)(U + (size_t)(t0 + jb + w - 2) * 3072 + 2432 + ch) : (u32x4){0u, 0u, 0u, 0u};
    }
    float cw[5][8], cb[8];
#pragma unroll
    for (int w = 0; w < 5; ++w) {
      const float4 c0 = *(const float4*)(p.in[25] + (size_t)(l * 5 + w) * 512 + ch), c1 = *(const float4*)(p.in[25] + (size_t)(l * 5 + w) * 512 + ch + 4);
      cw[w][0] = c0.x; cw[w][1] = c0.y; cw[w][2] = c0.z; cw[w][3] = c0.w; cw[w][4] = c1.x; cw[w][5] = c1.y; cw[w][6] = c1.z; cw[w][7] = c1.w;
    }
    {
      const float4 c0 = *(const float4*)(p.in[26] + l * 512 + ch), c1 = *(const float4*)(p.in[26] + l * 512 + ch + 4);
      cb[0] = c0.x; cb[1] = c0.y; cb[2] = c0.z; cb[3] = c0.w; cb[4] = c1.x; cb[5] = c1.y; cb[6] = c1.z; cb[7] = c1.w;
    }
#pragma unroll
    for (int jj = 0; jj < 8; ++jj) {
      const int j = jb + jj;
      float a[8];
#pragma unroll
      for (int e = 0; e < 8; ++e) a[e] = cb[e];
#pragma unroll
      for (int w = 0; w < 5; ++w)
#pragma unroll
        for (int e = 0; e < 4; ++e) { a[2 * e] += lo2f(xr[jj + w][e]) * cw[w][2 * e]; a[2 * e + 1] += hi2f(xr[jj + w][e]) * cw[w][2 * e + 1]; }
#pragma unroll
      for (int e = 0; e < 8; ++e) a[e] = silu(a[e]);
      u32x4 o; o[0] = pack2(a[0], a[1]); o[1] = pack2(a[2], a[3]); o[2] = pack2(a[4], a[5]); o[3] = pack2(a[6], a[7]);
      *(u32x4*)(XBC + (size_t)(t0 + j) * 512 + ch) = o;
      if (co < 16) {
#pragma unroll
        for (int e = 0; e < 8; ++e) XsT[(co * 8 + e) * 72 + j] = f2bf(a[e]);
      } else if (co < 24) {
        const int s2 = (co - 16) * 8;
#pragma unroll
        for (int cb4 = 0; cb4 < 4; ++cb4) {
          const float wj = WJ[cb4 * 64 + j];
#pragma unroll
          for (int e = 0; e < 8; ++e) BwT[(cb4 * 64 + s2 + e) * 72 + j] = f2bf(a[e] * wj);
        }
      }
    }
  }
  __syncthreads();
  {
    const int lane = tid & 63, w = tid >> 6, r = lane & 15, g = lane >> 4;
    const int dir = w >> 1, hd = w & 1, head = grp * 2 + hd;
    float* ST = (float*)(p.ws + WS_SST) + (size_t)((tt * 2 + dir) * 4 + head) * 4096;
    for (int pt = 0; pt < 4; ++pt) {
      bf16x8 b0 = ldfrag(XsT + (hd * 64 + pt * 16 + r) * 72 + g * 8), b1 = ldfrag(XsT + (hd * 64 + pt * 16 + r) * 72 + 32 + g * 8);
#pragma unroll
      for (int st = 0; st < 4; ++st) {
        f32x4 acc = (f32x4){0.f, 0.f, 0.f, 0.f};
        acc = mfma(ldfrag(BwT + (w * 64 + st * 16 + r) * 72 + g * 8), b0, acc);
        acc = mfma(ldfrag(BwT + (w * 64 + st * 16 + r) * 72 + 32 + g * 8), b1, acc);
        *(float4*)(ST + (pt * 16 + r) * 64 + st * 16 + g * 4) = make_float4(acc[0], acc[1], acc[2], acc[3]);
      }
    }
    if (tid < 4) ((float*)(p.ws + WS_SDEC))[(tt * 2 + (tid >> 1)) * 4 + grp * 2 + (tid & 1)] = __expf(TOT[tid]);
  }
  __syncthreads();
}

template <int KS>
DI void attn_block(const u16* __restrict__ Q, int qstride, const u16* __restrict__ K, int kstride, const u16* __restrict__ VT, int nk,
                   const u16* __restrict__ gate, u16* ocat, int tokb, char* smem) {
  constexpr int KLD = KS == 2 ? 64 : 128;
  constexpr int BUF = 64 * KLD + 64 * 64;
  constexpr int KCH = KS * 4;
  u16* sm = (u16*)smem;
  const int tid = otid(), lane = tid & 63, w = tid >> 6, r = lane & 15, g = lane >> 4;
  const int tok0 = tokb + w * 32;
  bf16x8 qf[2][KS];
#pragma unroll
  for (int q = 0; q < 2; ++q)
#pragma unroll
    for (int s = 0; s < KS; ++s) qf[q][s] = ldfrag(Q + (size_t)(tok0 + q * 16 + r) * qstride + s * 32 + g * 8);
  f32x4 o[2][4];
#pragma unroll
  for (int q = 0; q < 2; ++q)
#pragma unroll
    for (int e = 0; e < 4; ++e) o[q][e] = (f32x4){0.f, 0.f, 0.f, 0.f};
  float m[2] = {-1e30f, -1e30f}, lsum[2] = {0.f, 0.f};
  u32x4 rk0[KS], rv0[2], rk1[KS], rv1[2];
  int koff[KS], voff[2];
#pragma unroll
  for (int i = 0; i < KS; ++i) {
    const int id = tid + 256 * i, row = id / KCH, ch = id % KCH;
    const int f = KS == 2 ? (((row >> 1) & 1) | (((row >> 3) & 3) << 1)) : ((row & 3) | (((row >> 3) & 3) << 2));
    koff[i] = row * KLD + ((ch ^ f) * 8);
  }
#pragma unroll
  for (int i = 0; i < 2; ++i) { const int id = tid + 256 * i, row = id >> 3, ch = id & 7; voff[i] = 64 * KLD + row * 64 + ((ch ^ ((row >> 1) & 7)) * 8); }
  const int nit = nk >> 6;
  const int qtile = (tokb >> 7) & 15;
  const int start = (qtile * nit) >> 4;
  auto gload = [&](u32x4* rk, u32x4* rv, int it) {
    int tix = it + start; if (tix >= nit) tix -= nit;
    const int k0 = tix * 64;
#pragma unroll
    for (int i = 0; i < KS; ++i) { const int id = tid + 256 * i; rk[i] = *(const u32x4*)(K + (size_t)(k0 + id / KCH) * kstride + (id % KCH) * 8); }
#pragma unroll
    for (int i = 0; i < 2; ++i) { const int id = tid + 256 * i; rv[i] = *(const u32x4*)(VT + (size_t)(id >> 3) * nk + k0 + (id & 7) * 8); }
  };
  auto lstore = [&](const u32x4* rk, const u32x4* rv, int bufi) {
    u16* nb = sm + bufi * BUF;
#pragma unroll
    for (int i = 0; i < KS; ++i) *(u32x4*)(nb + koff[i]) = rk[i];
#pragma unroll
    for (int i = 0; i < 2; ++i) *(u32x4*)(nb + voff[i]) = rv[i];
  };
  const int krow0 = (r >> 2) * 8 + (r & 3);
  const int fk = KS == 2 ? (((krow0 >> 1) & 1) | (((krow0 >> 3) & 3) << 1)) : ((krow0 & 3) | (((krow0 >> 3) & 3) << 2));
  const int fv = (r >> 1) & 7;
  auto compute = [&](int bufi) {
    const u16* kb = sm + bufi * BUF; const u16* vb = kb + 64 * KLD;
    f32x4 sc[2][2][2];
#pragma unroll
    for (int sb = 0; sb < 2; ++sb) {
      const int krow = sb * 32 + krow0;
#pragma unroll
      for (int q = 0; q < 2; ++q) { sc[q][sb][0] = (f32x4){0.f, 0.f, 0.f, 0.f}; sc[q][sb][1] = sc[q][sb][0]; }
#pragma unroll
      for (int s = 0; s < KS; ++s) {
        const int co = ((s * 4 + g) ^ fk) * 8;
        const bf16x8 k0f = ldfrag(kb + krow * KLD + co), k1f = ldfrag(kb + (krow + 4) * KLD + co);
#pragma unroll
        for (int q = 0; q < 2; ++q) { sc[q][sb][0] = mfma(k0f, qf[q][s], sc[q][sb][0]); sc[q][sb][1] = mfma(k1f, qf[q][s], sc[q][sb][1]); }
      }
    }
    bf16x8 pf[2][2];
#pragma unroll
    for (int q = 0; q < 2; ++q) {
      float mx = fmaxf(fmaxf(fmaxf(sc[q][0][0][0], sc[q][0][0][1]), fmaxf(sc[q][0][0][2], sc[q][0][0][3])), fmaxf(fmaxf(sc[q][0][1][0], sc[q][0][1][1]), fmaxf(sc[q][0][1][2], sc[q][0][1][3])));
      const float mx1 = fmaxf(fmaxf(fmaxf(sc[q][1][0][0], sc[q][1][0][1]), fmaxf(sc[q][1][0][2], sc[q][1][0][3])), fmaxf(fmaxf(sc[q][1][1][0], sc[q][1][1][1]), fmaxf(sc[q][1][1][2], sc[q][1][1][3])));
      mx = fmaxf(mx, mx1);
      mx = xmax16(mx); mx = xmax32(mx);
      if (__any(mx > m[q] + 8.f)) {
        const float mnew = fmaxf(m[q], mx);
        const float alpha = __builtin_amdgcn_exp2f(m[q] - mnew);
        m[q] = mnew;
        lsum[q] *= alpha;
#pragma unroll
        for (int e = 0; e < 4; ++e) o[q][e] = o[q][e] * alpha;
      }
#pragma unroll
      for (int sb = 0; sb < 2; ++sb) {
        float pp[8];
#pragma unroll
        for (int i = 0; i < 4; ++i) { pp[i] = __builtin_amdgcn_exp2f(sc[q][sb][0][i] - m[q]); pp[4 + i] = __builtin_amdgcn_exp2f(sc[q][sb][1][i] - m[q]); }
        lsum[q] += ((pp[0] + pp[1]) + (pp[2] + pp[3])) + ((pp[4] + pp[5]) + (pp[6] + pp[7]));
        u32x4 pk; pk[0] = pack2(pp[0], pp[1]); pk[1] = pack2(pp[2], pp[3]); pk[2] = pack2(pp[4], pp[5]); pk[3] = pack2(pp[6], pp[7]);
        pf[q][sb] = __builtin_bit_cast(bf16x8, pk);
      }
    }
#pragma unroll
    for (int sb = 0; sb < 2; ++sb) {
      const int vo = ((sb * 4 + g) ^ fv) * 8;
#pragma unroll
      for (int e = 0; e < 4; ++e) {
        const bf16x8 vf = ldfrag(vb + (e * 16 + r) * 64 + vo);
        o[0][e] = mfma(vf, pf[0][sb], o[0][e]);
        o[1][e] = mfma(vf, pf[1][sb], o[1][e]);
      }
    }
  };
  gload(rk0, rv0, 0);
  gload(rk1, rv1, 1);
  lstore(rk0, rv0, 0);
  __syncthreads();
  for (int it = 0; it < nit; it += 2) {
    if (it + 2 < nit) gload(rk0, rv0, it + 2);
    compute(0);
    lstore(rk1, rv1, 1);
    __syncthreads();
    if (it + 3 < nit) gload(rk1, rv1, it + 3);
    compute(1);
    if (it + 2 < nit) lstore(rk0, rv0, 0);
    __syncthreads();
  }
#pragma unroll
  for (int q = 0; q < 2; ++q) {
    float lt = lsum[q];
    lt = xsum16(lt); lt = xsum32(lt);
    const float inv = 1.f / lt;
    const int tok = tok0 + q * 16 + r;
#pragma unroll
    for (int e = 0; e < 4; ++e) {
      const int dv = e * 16 + g * 4;
      float gt[4]; ld4bf(gate + (size_t)tok * 3072 + dv, gt);
      st4bf(ocat + (size_t)tok * 1024 + dv, o[q][e][0] * inv * silu(gt[0]), o[q][e][1] * inv * silu(gt[1]), o[q][e][2] * inv * silu(gt[2]), o[q][e][3] * inv * silu(gt[3]));
    }
  }
}

DI void d_attn(const P& p, int kind, int seqtok0, int kvoff, int nk, int h, int qt, char* smem) {
  const u16* U = (const u16*)(p.ws + WS_U); u16* Ocat = (u16*)(p.ws + WS_H);
  const int tokb = seqtok0 + qt * 128;
  if (kind == 0) {
    const u16* Qg = (const u16*)(p.ws + WS_QG); const u16* Kg = (const u16*)(p.ws + WS_KG); const u16* VgT = (const u16*)(p.ws + WS_VGT);
    attn_block<2>(Qg + h * 64, 256, Kg + (size_t)kvoff * 128 + (h >> 1) * 64, 128, VgT + (size_t)kvoff * 128 + (size_t)(h >> 1) * 64 * nk, nk, U + 512 + h * 64, Ocat + h * 64, tokb, smem);
  } else {
    const u16* Qm = (const u16*)(p.ws + WS_QM); const u16* Km = (const u16*)(p.ws + WS_KM); const u16* VmT = (const u16*)(p.ws + WS_VMT);
    attn_block<3>(Qm + h * 96, 384, Km + (size_t)kvoff * 384 + h * 96, 384, VmT + (size_t)kvoff * 256 + (size_t)h * 64 * nk, nk, U + 1920 + h * 64, Ocat + 512 + h * 64, tokb, smem);
  }
}

DI void d_gla(const P& p, int l, int tt, int h, char* smem) {
  const TI ti = tile_info(tt);
  const int t0 = ti.t0;
  float* CB = (float*)smem; float* TT = CB + 4096;
  u16* ATT = (u16*)smem;
  u16* Qd = (u16*)(TT + 64);
  u16* Kin = Qd + 2 * 64 * 40;
  u16* VT = Kin + 2 * 64 * 40;
  u16* ST = VT + 64 * 72;
  const u16* U = (const u16*)(p.ws + WS_U);
  const int tid = otid();
  {
    const float* src = (const float*)(p.ws + WS_CBG) + (size_t)(tt * 4 + h) * 4160;
#pragma unroll
    for (int i = 0; i < 4; ++i) *(float4*)(CB + (tid + 256 * i) * 4) = *(const float4*)(src + (tid + 256 * i) * 4);
    if (tid < 16) *(float4*)(TT + tid * 4) = *(const float4*)(src + 4096 + tid * 4);
  }
  __syncthreads();
  {
    const int tok = tid >> 2, sub = tid & 3;
    float q[8], k[8];
    ld8bf(U + (size_t)(t0 + tok) * 3072 + 768 + h * 32 + sub * 8, q);
    ld8bf(U + (size_t)(t0 + tok) * 3072 + 896 + h * 32 + sub * 8, k);
#pragma unroll
    for (int dir = 0; dir < 2; ++dir) {
      float qd[8], ki[8];
#pragma unroll
      for (int e = 0; e < 8; ++e) { const float cb = CB[(dir * 64 + tok) * 32 + sub * 8 + e]; qd[e] = q[e] * 0.17677669529f * __expf(cb); ki[e] = k[e] * __expf(-cb); }
      st4bf(Qd + (dir * 64 + tok) * 40 + sub * 8, qd[0], qd[1], qd[2], qd[3]); st4bf(Qd + (dir * 64 + tok) * 40 + sub * 8 + 4, qd[4], qd[5], qd[6], qd[7]);
      st4bf(Kin + (dir * 64 + tok) * 40 + sub * 8, ki[0], ki[1], ki[2], ki[3]); st4bf(Kin + (dir * 64 + tok) * 40 + sub * 8 + 4, ki[4], ki[5], ki[6], ki[7]);
    }
    const u16* vs = U + (size_t)(t0 + tok) * 3072 + 1024 + h * 64 + sub * 16;
    u32x4 v0 = *(const u32x4*)vs, v1 = *(const u32x4*)(vs + 8);
#pragma unroll
    for (int e = 0; e < 4; ++e) {
      VT[(sub * 16 + e * 2) * 72 + tok] = (u16)(v0[e] & 0xffffu); VT[(sub * 16 + e * 2 + 1) * 72 + tok] = (u16)(v0[e] >> 16);
      VT[(sub * 16 + 8 + e * 2) * 72 + tok] = (u16)(v1[e] & 0xffffu); VT[(sub * 16 + 8 + e * 2 + 1) * 72 + tok] = (u16)(v1[e] >> 16);
    }
  }
  {
    const int d = tid >> 3, e0 = (tid & 7) * 8;
    const float* GUPD = (const float*)(p.ws + WS_GUPD);
#pragma unroll
    for (int dir = 0; dir < 2; ++dir) {
      const float* up = GUPD + (size_t)((tt * 2 + dir) * 4 + h) * 2048 + tid * 8;
      const float4 a = *(const float4*)up, b4 = *(const float4*)(up + 4);
      const float S[8] = {a.x, a.y, a.z, a.w, b4.x, b4.y, b4.z, b4.w};
#pragma unroll
      for (int e = 0; e < 8; ++e) ST[(dir * 64 + e0 + e) * 40 + d] = f2bf(S[e]);
    }
  }
  __syncthreads();
  const int lane = tid & 63, w = tid >> 6, r = lane & 15, g = lane >> 4;
  f32x4 o[4];
#pragma unroll
  for (int e = 0; e < 4; ++e) o[e] = (f32x4){0.f, 0.f, 0.f, 0.f};
  for (int dir = 0; dir < 2; ++dir) {
    const bf16x8 bq = ldfrag(Qd + (dir * 64 + w * 16 + r) * 40 + g * 8);
    const int itok = w * 16 + r;
#pragma unroll
    for (int jt = 0; jt < 4; ++jt) {
      f32x4 s = mfma(ldfrag(Kin + (dir * 64 + jt * 16 + r) * 40 + g * 8), bq, (f32x4){0.f, 0.f, 0.f, 0.f});
      float v[4];
#pragma unroll
      for (int i = 0; i < 4; ++i) { const int j = jt * 16 + g * 4 + i; const bool keep = dir == 0 ? (j <= itok) : (j >= itok); v[i] = keep ? s[i] : 0.f; }
      st4bf(ATT + itok * 72 + jt * 16 + g * 4, v[0], v[1], v[2], v[3]);
    }
    __syncthreads();
#pragma unroll
    for (int s = 0; s < 2; ++s) {
      const bf16x8 bt = ldfrag(ATT + (w * 16 + r) * 72 + s * 32 + g * 8);
#pragma unroll
      for (int et = 0; et < 4; ++et) o[et] = mfma(ldfrag(VT + (et * 16 + r) * 72 + s * 32 + g * 8), bt, o[et]);
    }
#pragma unroll
    for (int et = 0; et < 4; ++et) o[et] = mfma(ldfrag(ST + (dir * 64 + et * 16 + r) * 40 + g * 8), bq, o[et]);
    __syncthreads();
  }
  float ss = 0;
#pragma unroll
  for (int et = 0; et < 4; ++et) ss += o[et][0] * o[et][0] + o[et][1] * o[et][1] + o[et][2] * o[et][2] + o[et][3] * o[et][3];
  ss = xsum16(ss); ss = xsum32(ss);
  const float rr = rsqrtf(ss * (1.f / 64.f) + EPS);
  const int t = t0 + w * 16 + r;
  u16* Ocat = (u16*)(p.ws + WS_H);
#pragma unroll
  for (int et = 0; et < 4; ++et) {
    const int e = et * 16 + g * 4;
    float gt[4]; ld4bf(U + (size_t)t * 3072 + 1312 + h * 64 + e, gt);
    const float4 gn = *(const float4*)(p.in[20] + l * 64 + e);
    st4bf(Ocat + (size_t)t * 1024 + 256 + h * 64 + e, o[et][0] * rr * gn.x * silu(gt[0]), o[et][1] * rr * gn.y * silu(gt[1]), o[et][2] * rr * gn.z * silu(gt[2]), o[et][3] * rr * gn.w * silu(gt[3]));
  }
  __syncthreads();
}

DI void d_ssd(const P& p, int l, int tt, int grp, char* smem) {
  const TI ti = tile_info(tt);
  const int t0 = ti.t0;
  u16* XsT = (u16*)smem;
  u16* Bm = XsT + 128 * 72;
  u16* Cm = Bm + 64 * 72;
  u16* M = Cm + 64 * 72;
  u16* Hst = M + 64 * 72;
  float* DT = (float*)(Hst + 64 * 72);
  float* CUM = DT + 512; float* TOT = CUM + 512;
  const u16* U = (const u16*)(p.ws + WS_U);
  const float* SIDE = (const float*)(p.ws + WS_SIDE);
  const u16* XBC = (const u16*)(p.ws + WS_XBC);
  const float* SST = (const float*)(p.ws + WS_SST);
  const int tid = otid(), lane = tid & 63, w = tid >> 6, r = lane & 15, g = lane >> 4;
  {
    const int tok = tid & 63, head = tid >> 6;
#pragma unroll
    for (int dir = 0; dir < 2; ++dir) {
      const float raw = SIDE[(size_t)(t0 + tok) * 40 + 32 + dir * 4 + head] + p.in[27][(l * 2 + dir) * 4 + head];
      const float dt = softplus(raw);
      DT[(dir * 4 + head) * 64 + tok] = dt; CUM[(dir * 4 + head) * 64 + tok] = -__expf(p.in[28][(l * 2 + dir) * 4 + head]) * dt;
    }
  }
  __syncthreads();
  {
#pragma unroll
    for (int dir = 0; dir < 2; ++dir) {
      const int cb8 = dir * 4 + w;
      const int j = dir ? 63 - lane : lane;
      float v = CUM[cb8 * 64 + j];
      v = wave_incl_scan(v, lane);
      CUM[cb8 * 64 + j] = v;
      if (lane == 63) TOT[cb8] = v;
    }
  }
  float ss = 0;
  const int itok = w * 16 + r;
  const int t = t0 + itok;
  {
    f32x4 y[2][4];
#pragma unroll
    for (int a = 0; a < 2; ++a)
#pragma unroll
      for (int b = 0; b < 4; ++b) y[a][b] = (f32x4){0.f, 0.f, 0.f, 0.f};
    __syncthreads();
    {
      const int tok = tid >> 2, sub = tid & 3;
      const u16* xs = XBC + (size_t)(t0 + tok) * 512 + grp * 128 + sub * 32;
#pragma unroll
      for (int q = 0; q < 4; ++q) {
        u32x4 v = *(const u32x4*)(xs + q * 8);
#pragma unroll
        for (int e = 0; e < 4; ++e) { XsT[(sub * 32 + q * 8 + e * 2) * 72 + tok] = (u16)(v[e] & 0xffffu); XsT[(sub * 32 + q * 8 + e * 2 + 1) * 72 + tok] = (u16)(v[e] >> 16); }
      }
      const u16* bs = XBC + (size_t)(t0 + tok) * 512 + 256 + grp * 64 + sub * 16;
      *(u32x4*)(Bm + tok * 72 + sub * 16) = *(const u32x4*)bs; *(u32x4*)(Bm + tok * 72 + sub * 16 + 8) = *(const u32x4*)(bs + 8);
      const u16* cs = XBC + (size_t)(t0 + tok) * 512 + 384 + grp * 64 + sub * 16;
      *(u32x4*)(Cm + tok * 72 + sub * 16) = *(const u32x4*)cs; *(u32x4*)(Cm + tok * 72 + sub * 16 + 8) = *(const u32x4*)(cs + 8);
    }
    __syncthreads();
    f32x4 sc[4];
    const bf16x8 c0 = ldfrag(Cm + (w * 16 + r) * 72 + g * 8), c1 = ldfrag(Cm + (w * 16 + r) * 72 + 32 + g * 8);
#pragma unroll
    for (int jt = 0; jt < 4; ++jt) {
      sc[jt] = mfma(ldfrag(Bm + (jt * 16 + r) * 72 + g * 8), c0, (f32x4){0.f, 0.f, 0.f, 0.f});
      sc[jt] = mfma(ldfrag(Bm + (jt * 16 + r) * 72 + 32 + g * 8), c1, sc[jt]);
    }
#pragma unroll
    for (int hd = 0; hd < 2; ++hd) {
      const int head = grp * 2 + hd;
      for (int dir = 0; dir < 2; ++dir) {
        const int cb8 = dir * 4 + head;
        const float ci = CUM[cb8 * 64 + itok];
#pragma unroll
        for (int jt = 0; jt < 4; ++jt) {
          float v[4];
#pragma unroll
          for (int i = 0; i < 4; ++i) {
            const int j = jt * 16 + g * 4 + i; const bool keep = dir == 0 ? (j <= itok) : (j >= itok);
            v[i] = keep ? sc[jt][i] * __expf(ci - CUM[cb8 * 64 + j]) * DT[cb8 * 64 + j] : 0.f;
          }
          st4bf(M + itok * 72 + jt * 16 + g * 4, v[0], v[1], v[2], v[3]);
        }
        {
          const int pp = tid >> 2, s0 = (tid & 3) * 16;
          const float* st = SST + (size_t)((tt * 2 + dir) * 4 + head) * 4096 + tid * 16;
          const float4 h0 = ((const float4*)st)[0], h1 = ((const float4*)st)[1], h2 = ((const float4*)st)[2], h3 = ((const float4*)st)[3];
          st4bf(Hst + pp * 72 + s0, h0.x, h0.y, h0.z, h0.w); st4bf(Hst + pp * 72 + s0 + 4, h1.x, h1.y, h1.z, h1.w);
          st4bf(Hst + pp * 72 + s0 + 8, h2.x, h2.y, h2.z, h2.w); st4bf(Hst + pp * 72 + s0 + 12, h3.x, h3.y, h3.z, h3.w);
        }
        __syncthreads();
        const float ei = __expf(ci);
        const bf16x8 m0 = ldfrag(M + (w * 16 + r) * 72 + g * 8), m1 = ldfrag(M + (w * 16 + r) * 72 + 32 + g * 8);
#pragma unroll
        for (int pt = 0; pt < 4; ++pt) {
          y[hd][pt] = mfma(ldfrag(XsT + (hd * 64 + pt * 16 + r) * 72 + g * 8), m0, y[hd][pt]);
          y[hd][pt] = mfma(ldfrag(XsT + (hd * 64 + pt * 16 + r) * 72 + 32 + g * 8), m1, y[hd][pt]);
          f32x4 tmp = mfma(ldfrag(Hst + (pt * 16 + r) * 72 + g * 8), c0, (f32x4){0.f, 0.f, 0.f, 0.f});
          tmp = mfma(ldfrag(Hst + (pt * 16 + r) * 72 + 32 + g * 8), c1, tmp);
          y[hd][pt] = y[hd][pt] + tmp * ei;
        }
        __syncthreads();
      }
      const float dsk = p.in[29][l * 4 + head];
#pragma unroll
      for (int pt = 0; pt < 4; ++pt) {
        float z[4]; ld4bf(U + (size_t)t * 3072 + 2176 + head * 64 + pt * 16 + g * 4, z);
        float v[4];
#pragma unroll
        for (int i = 0; i < 4; ++i) {
          v[i] = (y[hd][pt][i] + dsk * bf2f(XsT[(hd * 64 + pt * 16 + g * 4 + i) * 72 + itok])) * silu(z[i]);
          ss += v[i] * v[i];
        }
        const int c = head * 64 + pt * 16 + g * 4;
        const float4 gn = *(const float4*)(p.in[30] + l * 256 + c);
        st4bf((u16*)(p.ws + WS_H) + (size_t)t * 1024 + 768 + c, v[0] * gn.x, v[1] * gn.y, v[2] * gn.z, v[3] * gn.w);
      }
    }
  }
  ss = xsum16(ss); ss = xsum32(ss);
  if (g == 0) ((float*)(p.ws + WS_SSQ))[t * 2 + grp] = ss;
  __syncthreads();
}


DI void phaseS(const P& p, int l) {
  const int tid = otid();
  float* GUPD = (float*)(p.ws + WS_GUPD); const float* GDEC = (const float*)(p.ws + WS_GDEC);
  float* SST = (float*)(p.ws + WS_SST); const float* SDEC = (const float*)(p.ws + WS_SDEC);
  const int total = 34 * 8 * 1536;
  for (int idx = blockIdx.x * 256 + tid; idx < total; idx += gridDim.x * 256) {
    const int e = idx % 1536; const int rest = idx / 1536; const int head = rest & 3, dir = (rest >> 2) & 1, seq = rest >> 3;
    int nc, tt0, isctx, b;
    if (seq < 32) { nc = 4; tt0 = seq * 4; isctx = 1; b = seq; } else { nc = 32; tt0 = 128 + (seq - 32) * 32; isctx = 0; b = seq - 32; }
    const bool gla = e < 512;
    const int e4 = gla ? e * 4 : (e - 512) * 4;
    const int esz = gla ? 2048 : 4096;
    float* base = gla ? GUPD : SST;
    const float* s0p = (gla ? p.in[7] : p.in[8]) + (size_t)(((b * 2 + l) * 2 + dir) * 4 + head) * esz + e4;
    float4 S = isctx ? make_float4(0.f, 0.f, 0.f, 0.f) : *(const float4*)s0p;
    for (int q0 = 0; q0 < nc; q0 += 4) {
      float4 u[4]; float dec[4]; float4* up[4];
#pragma unroll
      for (int k = 0; k < 4; ++k) {
        const int cc = dir == 0 ? q0 + k : nc - 1 - (q0 + k);
        const int chunk = tt0 + cc;
        up[k] = (float4*)(base + (size_t)((chunk * 2 + dir) * 4 + head) * esz + e4);
        u[k] = *up[k];
        dec[k] = gla ? GDEC[((chunk * 2 + dir) * 4 + head) * 32 + (e4 >> 6)] : SDEC[(chunk * 2 + dir) * 4 + head];
      }
#pragma unroll
      for (int k = 0; k < 4; ++k) {
        *up[k] = S;
        S.x = dec[k] * S.x + u[k].x; S.y = dec[k] * S.y + u[k].y; S.z = dec[k] * S.z + u[k].z; S.w = dec[k] * S.w + u[k].w;
      }
    }
    if (isctx) *(float4*)(p.out + (gla ? OUT_SG : OUT_SS) + (size_t)(((b * 2 + l) * 2 + dir) * 4 + head) * esz + e4) = S;
  }
}

DI void phaseB(const P& p, int l, char* smem) {
  const int xcd = blockIdx.x & 7, slot = blockIdx.x >> 3, nslot = gridDim.x >> 3;
  for (int i = slot; i < 288; i += nslot) {
    const int ntb = i / 96, rem = i % 96;
    gemm_tile<0>((const u16*)(p.ws + WS_H), (const u16*)(p.ws + WS_WINT) + (size_t)l * 3072 * 1024, xcd * 12 + (rem >> 3), ntb * 8 + (rem & 7), p.ws + WS_U, (float*)(p.ws + WS_SIDE), smem);
  }
}
DI void phaseE(const P& p, int l, char* smem) {
  const int xcd = blockIdx.x & 7, slot = blockIdx.x >> 3, nslot = gridDim.x >> 3;
  for (int i = slot; i < 128; i += nslot)
    gemm_tile<1>((const u16*)(p.ws + WS_H), (const u16*)(p.ws + WS_WOUTT) + (size_t)l * 1024 * 1024, xcd * 16 + (i >> 3), i & 7, p.ws + WS_U, (float*)(p.ws + WS_SSQ), smem);
}
DI void phaseC(const P& p, int l, char* smem) {
  for (int job = blockIdx.x; job < 1744; job += gridDim.x) {
    if (job < 384) c_ssd(p, l, job >> 1, job & 1, smem);
    else if (job >= 400 && job < 416) c_cache(p, l, job - 400, smem);
    else if (job < 1360) { const int idx = job < 400 ? job - 384 : job - 400; if (idx < 768) c_gla(p, l, idx >> 2, idx & 3, smem); else c_gqa(p, l, idx - 768, smem); }
    else { const int idx = job - 1360; if (idx < 192) c_mla_q(p, l, idx, smem); else c_mla_kv(p, l, idx - 192, smem); }
  }
}
DI void d_light(const P& p, int l, int j, char* smem) {
  if (j < 384) d_ssd(p, l, j >> 1, j & 1, smem);
  else if (j < 1152) { const int q = j - 384; d_gla(p, l, q >> 2, q & 3, smem); }
  else {
    const int q = j - 1152; const int kind = q >> 8, rem = q & 255; const int seq = rem >> 3, h = (rem >> 1) & 3, qt = rem & 1;
    d_attn(p, kind, seq * 256, seq * 256, 256, h, qt, smem);
  }
}
DI void phaseD(const P& p, int l, char* smem) {
  const int bid = blockIdx.x, G = gridDim.x;
  for (int step = 0;; ++step) {
    int heavy = -1, light = -1;
    if (G == 512) {
      if (step > 4) break;
      if (bid < 256) { if (step == 0) heavy = bid; else if (step == 1) light = 1152 + bid; else if (step == 2) light = 896 + bid; }
      else {
        const int nb = bid - 256;
        if (nb < 128) { if (step < 4) light = step * 128 + nb; }
        else if (step < 3) light = 384 + step * 128 + nb;
        else light = 1408 + (nb - 128) * 2 + (step - 3);
      }
    } else {
      const int job = bid + step * G;
      if (job >= 256 + 1664) break;
      if (job < 256) heavy = job; else light = job - 256;
    }
    if (heavy >= 0) {
      const int combo = (heavy & 7) * 2 + (heavy >> 7), qt = (heavy >> 3) & 15;
      const int kind = combo >> 3, b = (combo >> 2) & 1, h = combo & 3;
      d_attn(p, kind, 8192 + b * 2048, 8192 + b * 2560, 2560, h, qt, smem);
    } else if (light >= 0) d_light(p, l, light, smem);
  }
}

__global__ void __launch_bounds__(256, 2) mega(P p) {
  __shared__ __attribute__((aligned(16))) char smem[SMEM_BYTES];
  __shared__ uint4 xb_words;
  if (threadIdx.x == 0) xb_words = make_uint4(0u, 0u, 0u, 0u);
  __syncthreads();
  const XcdBarrier xb = xcd_barrier_post((unsigned*)(p.ws + WS_BAR), (volatile LAS unsigned*)&xb_words);
  if (p.out == nullptr) cg::this_grid().sync();
  phase0(p, smem);
  xcd_barrier(xb);
  for (int l = 0; l < 2; ++l) {
    phaseA(p, l); xcd_barrier(xb);
    phaseB(p, l, smem); xcd_barrier(xb);
    phaseC(p, l, smem); xcd_barrier(xb);
    phaseS(p, l); xcd_barrier(xb);
    phaseD(p, l, smem); xcd_barrier(xb);
    phaseE(p, l, smem); xcd_barrier(xb);
  }
  phaseA(p, 2);
}

extern "C" void kernel_launch(void* const* d_in, const int* in_sizes, int n_in, void* d_out, int out_size, void* d_ws, size_t ws_size, hipStream_t stream) {
  static int grid_blocks = 0;
  if (!grid_blocks) {
    int dev = 0, cus = 0, per_cu = 0;
    hipGetDevice(&dev);
    hipDeviceGetAttribute(&cus, hipDeviceAttributeMultiprocessorCount, dev);
    hipOccupancyMaxActiveBlocksPerMultiprocessor(&per_cu, mega, 256, 0);
    if (per_cu > 2) per_cu = 2;
    if (per_cu < 1) per_cu = 1;
    grid_blocks = cus * per_cu;
  }
  P p{};
  for (int i = 0; i < 31; ++i) p.in[i] = (const float*)d_in[i];
  p.out = (float*)d_out;
  p.ws = (char*)d_ws;
  hipMemsetAsync((char*)d_ws + WS_BAR, 0, XCD_BAR_WORDS * sizeof(unsigned), stream);
  void* args[] = {&p};
  hipError_t e = hipLaunchCooperativeKernel((void*)mega, dim3(grid_blocks), dim3(256), args, 0, stream);
  if (e != hipSuccess) fprintf(stderr, "cooperative launch failed: %s (grid %d)\n", hipGetErrorString(e), grid_blocks);
}
#ifdef SPLIT_TEST
__global__ void __launch_bounds__(256, 2) k_p0(P p) { __shared__ __attribute__((aligned(16))) char smem[SMEM_BYTES]; phase0(p, smem); }
__global__ void __launch_bounds__(256, 2) k_a(P p, int l) { phaseA(p, l); }
__global__ void __launch_bounds__(256, 2) k_b(P p, int l) { __shared__ __attribute__((aligned(16))) char smem[SMEM_BYTES]; phaseB(p, l, smem); }
__global__ void __launch_bounds__(256, 2) k_e(P p, int l) { __shared__ __attribute__((aligned(16))) char smem[SMEM_BYTES]; phaseE(p, l, smem); }
__global__ void __launch_bounds__(256, 2) k_cmla(P p, int l) { __shared__ __attribute__((aligned(16))) char smem[SMEM_BYTES]; c_mla_q(p, l, blockIdx.x, smem); c_mla_kv(p, l, blockIdx.x, smem); }
__global__ void __launch_bounds__(256, 2) k_ccache(P p, int l) { __shared__ __attribute__((aligned(16))) char smem[SMEM_BYTES]; c_cache(p, l, blockIdx.x, smem); }
__global__ void __launch_bounds__(256, 2) k_cssd(P p, int l) { __shared__ __attribute__((aligned(16))) char smem[SMEM_BYTES]; c_ssd(p, l, blockIdx.x, blockIdx.y, smem); }
__global__ void __launch_bounds__(256, 2) k_cgqa(P p, int l) { __shared__ __attribute__((aligned(16))) char smem[SMEM_BYTES]; c_gqa(p, l, blockIdx.x, smem); }
__global__ void __launch_bounds__(256, 2) k_cgla(P p, int l) { __shared__ __attribute__((aligned(16))) char smem[SMEM_BYTES]; c_gla(p, l, blockIdx.x, blockIdx.y, smem); }
__global__ void __launch_bounds__(256, 2) k_dattn(P p, int l) { __shared__ __attribute__((aligned(16))) char smem[SMEM_BYTES]; d_attn(p, blockIdx.y, 0, 0, 256 + 256 * l, blockIdx.x & 3, blockIdx.x >> 2, smem); }
__global__ void __launch_bounds__(256, 2) k_dgla(P p, int l) { __shared__ __attribute__((aligned(16))) char smem[SMEM_BYTES]; d_gla(p, l, blockIdx.x, blockIdx.y, smem); }
__global__ void __launch_bounds__(256, 2) k_dssd(P p, int l) { __shared__ __attribute__((aligned(16))) char smem[SMEM_BYTES]; d_ssd(p, l, blockIdx.x, blockIdx.y, smem); }
#endif
```
